# Optimizing an MI355X kernel written in HIP

```python
import math
import jax, jax.numpy as jnp
from jax import lax
import numpy as np

D_MODEL = 1024
BATCH = 8
SEQ = 8192
DEPTH = 2

HEAD_DIM = 64
ROT_DIM = HEAD_DIM // 4
ROPE_THETA = 500000.0
DIFF_HEADS = 4
DIFF_VDIM = 2 * HEAD_DIM
DIFF_QK_WIDTH = DIFF_HEADS * 2 * HEAD_DIM
DIFF_V_WIDTH = DIFF_HEADS * DIFF_VDIM
DIL_HEADS = 8
DIL_WIDTH = DIL_HEADS * HEAD_DIM
DIL_PATTERNS = ((128, 1), (512, 4), (2048, 16))
RNN_WIDTH = D_MODEL
LRU_BLOCKS = 16
LRU_BLOCK = RNN_WIDTH // LRU_BLOCKS
LRU_C = 8.0
CONV_WIDTH = 4
N_BRANCHES = 3
Q_BLOCK = 128
MEM_TOKENS = 256
XATTN_HEADS = 4
XATTN_HEAD_DIM = D_MODEL // XATTN_HEADS
FFN_HIDDEN = -(-8 * D_MODEL // (3 * 256)) * 256
DEEPNORM_ALPHA = (2 * DEPTH) ** 0.25
DEEPNORM_BETA = (8 * DEPTH) ** -0.25
LN_EPS = 1e-5
IN_SPLITS = (DIFF_QK_WIDTH, DIFF_QK_WIDTH, DIFF_V_WIDTH, RNN_WIDTH, RNN_WIDTH,
             DIL_WIDTH, DIL_WIDTH, DIL_WIDTH, N_BRANCHES * D_MODEL)
IN_WIDTH = sum(IN_SPLITS)

kernel_name = "hybrid_diffattn_rglru_dilated_deepnorm"


def layer_norm(x, g, b):
    xf = x.astype(jnp.float32)
    mu = jnp.mean(xf, axis=-1, keepdims=True)
    var = jnp.mean(jnp.square(xf - mu), axis=-1, keepdims=True)
    y = (xf - mu) * lax.rsqrt(var + LN_EPS)
    return (y * g.astype(jnp.float32) + b.astype(jnp.float32)).astype(x.dtype)


def rms_norm(x, g):
    xf = x.astype(jnp.float32)
    y = xf * lax.rsqrt(jnp.mean(xf * xf, axis=-1, keepdims=True) + LN_EPS)
    return (y * g.astype(jnp.float32)).astype(x.dtype)


def partial_rotary(x, pos):
    half = ROT_DIM // 2
    inv_freq = jnp.power(ROPE_THETA, -2.0 * jnp.arange(half, dtype=jnp.float32) / ROT_DIM)
    ang = pos.astype(jnp.float32)[:, None] * inv_freq[None, :]
    shape = (1, ang.shape[0]) + (1,) * (x.ndim - 3) + (half,)
    cos = jnp.cos(ang).reshape(shape)
    sin = jnp.sin(ang).reshape(shape)
    xf = x.astype(jnp.float32)
    x1 = xf[..., :half]
    x2 = xf[..., half:ROT_DIM]
    out = jnp.concatenate([x1 * cos - x2 * sin, x2 * cos + x1 * sin, xf[..., ROT_DIM:]], axis=-1)
    return out.astype(x.dtype)


def diff_attention(q, k, v, lam, subln_g, lambda_init):
    B, S = q.shape[0], q.shape[1]
    nb = S // Q_BLOCK
    scale = HEAD_DIM ** -0.5
    kpos = jnp.arange(S)
    qb = q.reshape(B, nb, Q_BLOCK, DIFF_HEADS, 2, HEAD_DIM).transpose(1, 0, 2, 3, 4, 5)
    starts = jnp.arange(nb) * Q_BLOCK

    def block(args):
        qblk, start = args
        s = jnp.einsum('bqhcd,bkhcd->bhcqk', qblk, k).astype(jnp.float32) * scale
        causal = (start + jnp.arange(Q_BLOCK))[:, None] >= kpos[None, :]
        p = jax.nn.softmax(jnp.where(causal, s, -jnp.inf), axis=-1)
        w = p[:, :, 0] - lam * p[:, :, 1]
        return jnp.einsum('bhqk,bkhe->bqhe', w.astype(v.dtype), v)

    o = lax.map(block, (qb, starts))
    o = o.transpose(1, 0, 2, 3, 4).reshape(B, S, DIFF_HEADS, DIFF_VDIM)
    o = rms_norm(o, subln_g) * (1.0 - lambda_init)
    return o.reshape(B, S, DIFF_V_WIDTH)


def dilated_band_attention(q, k, v, dil, steps):
    B, S, H, Dh = q.shape
    pad = (-S) % (dil * steps)
    Sp = S + pad
    M = Sp // dil
    nb = M // steps

    def to_blocks(t):
        t = jnp.pad(t, ((0, 0), (0, pad), (0, 0), (0, 0)))
        t = t.reshape(B, M, dil, H, Dh).transpose(0, 2, 1, 3, 4)
        return t.reshape(B, dil, nb, steps, H, Dh)

    qb, kb, vb = to_blocks(q), to_blocks(k), to_blocks(v)
    zpad = ((0, 0), (0, 0), (1, 0), (0, 0), (0, 0), (0, 0))
    kk = jnp.concatenate([jnp.pad(kb, zpad)[:, :, :-1], kb], axis=3)
    vv = jnp.concatenate([jnp.pad(vb, zpad)[:, :, :-1], vb], axis=3)
    s = jnp.einsum('bpnqhd,bpnkhd->bpnhqk', qb, kk).astype(jnp.float32) * (Dh ** -0.5)
    i = jnp.arange(steps)[:, None]
    j = jnp.arange(2 * steps)[None, :]
    dist = steps + i - j
    band = (dist >= 0) & (dist <= steps)
    valid = band[None] & ((jnp.arange(nb)[:, None, None] > 0) | (j >= steps)[None])
    s = jnp.where(valid[None, None, :, None], s, -jnp.inf)
    lse = jax.nn.logsumexp(s, axis=-1)
    p = jnp.exp(s - lse[..., None])
    o = jnp.einsum('bpnhqk,bpnkhd->bpnqhd', p.astype(v.dtype), vv)
    o = o.reshape(B, dil, M, H, Dh).transpose(0, 2, 1, 3, 4).reshape(B, Sp, H, Dh)[:, :S]
    lse = lse.transpose(0, 1, 2, 4, 3).reshape(B, dil, M, H).transpose(0, 2, 1, 3).reshape(B, Sp, H)[:, :S]
    return o, lse


def dilated_attention(q, k, v):
    outs, lses = [], []
    for window, dil in DIL_PATTERNS:
        o, lse = dilated_band_attention(q, k, v, dil, window // dil)
        outs.append(o.astype(jnp.float32))
        lses.append(lse)
    wts = jax.nn.softmax(jnp.stack(lses, axis=0), axis=0)
    o = jnp.sum(wts[..., None] * jnp.stack(outs, axis=0), axis=0)
    B, S = q.shape[0], q.shape[1]
    return o.reshape(B, S, DIL_WIDTH).astype(q.dtype)


def rg_lru_branch(xr, gate, conv_w, conv_b, gate_w, gate_b, lru_lambda):
    B, S, _ = xr.shape
    xp = jnp.pad(xr, ((0, 0), (CONV_WIDTH - 1, 0), (0, 0)))
    xc = conv_b
    for tap in range(CONV_WIDTH):
        xc = xc + xp[:, tap:tap + S] * conv_w[tap]
    xb = xc.reshape(B, S, LRU_BLOCKS, LRU_BLOCK)
    gates = jnp.einsum('bsnc,gncd->gbsnd', xb, gate_w).reshape(2, B, S, RNN_WIDTH) + gate_b[:, None, None, :]
    r = jax.nn.sigmoid(gates[0].astype(jnp.float32))
    i = jax.nn.sigmoid(gates[1].astype(jnp.float32))
    log_a = -LRU_C * r * jax.nn.softplus(-lru_lambda.astype(jnp.float32))
    a = jnp.exp(log_a)
    u = jnp.sqrt(-jnp.expm1(2.0 * log_a)) * (i * xc.astype(jnp.float32))

    def step(h, inp):
        a_t, u_t = inp
        h = a_t * h + u_t
        return h, h

    _, hs = lax.scan(step, jnp.zeros((B, RNN_WIDTH), jnp.float32),
                     (a.transpose(1, 0, 2), u.transpose(1, 0, 2)))
    h = hs.transpose(1, 0, 2).astype(xr.dtype)
    return h * jax.nn.gelu(gate)


def hybrid_mixer(x, layer, w_in, lam_qk, diff_subln, conv_w, conv_b, gate_w, gate_b, lru_lambda,
                 w_br_a, w_br_b, w_br_c, w_out):
    B, S, _ = x.shape
    pos = jnp.arange(S)
    u = x @ w_in
    offsets = np.cumsum(IN_SPLITS)[:-1].tolist()
    aq, ak, av, rx, rg, cq, ck, cv, gl = jnp.split(u, offsets, axis=-1)
    lambda_init = 0.8 - 0.6 * math.exp(-0.3 * layer)
    lq = lam_qk.astype(jnp.float32)
    lam = jnp.exp(jnp.sum(lq[0] * lq[1])) - jnp.exp(jnp.sum(lq[2] * lq[3])) + lambda_init
    qa = partial_rotary(aq.reshape(B, S, DIFF_HEADS, 2, HEAD_DIM), pos)
    ka = partial_rotary(ak.reshape(B, S, DIFF_HEADS, 2, HEAD_DIM), pos)
    o_a = diff_attention(qa, ka, av.reshape(B, S, DIFF_HEADS, DIFF_VDIM), lam, diff_subln, lambda_init)
    o_b = rg_lru_branch(rx, rg, conv_w, conv_b, gate_w, gate_b, lru_lambda)
    qc = partial_rotary(cq.reshape(B, S, DIL_HEADS, HEAD_DIM), pos)
    kc = partial_rotary(ck.reshape(B, S, DIL_HEADS, HEAD_DIM), pos)
    o_c = dilated_attention(qc, kc, cv.reshape(B, S, DIL_HEADS, HEAD_DIM))
    g = jax.nn.sigmoid(gl.reshape(B, S, N_BRANCHES, D_MODEL))
    merged = g[:, :, 0] * (o_a @ w_br_a) + g[:, :, 1] * (o_b @ w_br_b) + g[:, :, 2] * (o_c @ w_br_c)
    return merged @ w_out


def memory_cross_attention(x, mem, wq, wkv, wo):
    B, S, _ = x.shape
    q = (x @ wq).reshape(B, S, XATTN_HEADS, XATTN_HEAD_DIM)
    k, v = jnp.split(mem @ wkv, 2, axis=-1)
    k = k.reshape(B, -1, XATTN_HEADS, XATTN_HEAD_DIM)
    v = v.reshape(B, -1, XATTN_HEADS, XATTN_HEAD_DIM)
    s = jnp.einsum('bqhd,bmhd->bhqm', q, k).astype(jnp.float32) * (XATTN_HEAD_DIM ** -0.5)
    p = jax.nn.softmax(s, axis=-1)
    o = jnp.einsum('bhqm,bmhd->bqhd', p.astype(v.dtype), v).reshape(B, S, D_MODEL)
    return o @ wo


def swiglu(x, w_up, w_down):
    gpart, upart = jnp.split(x @ w_up, 2, axis=-1)
    return (jax.nn.silu(gpart) * upart) @ w_down


def setup_inputs(seed: int = 0) -> dict:
    key = jax.random.key(seed)
    ks = iter(jax.random.split(key, 32))
    nrm = lambda shape, scale: jax.random.normal(next(ks), shape, jnp.float32) * scale
    L, D = DEPTH, D_MODEL
    u = jax.random.uniform(next(ks), (L, RNN_WIDTH), jnp.float32, minval=0.9, maxval=0.999)
    p = u ** (1.0 / LRU_C)
    lru_lambda = jnp.log(p) - jnp.log1p(-p)
    return {
        "x": nrm((BATCH, SEQ, D), 1.0),
        "mem": nrm((BATCH, MEM_TOKENS, D), 1.0),
        "w_in": nrm((L, D, IN_WIDTH), D ** -0.5),
        "lam_qk": nrm((L, 4, HEAD_DIM), 0.1),
        "diff_subln": 1.0 + nrm((L, DIFF_VDIM), 0.05),
        "conv_w": nrm((L, CONV_WIDTH, RNN_WIDTH), CONV_WIDTH ** -0.5),
        "conv_b": nrm((L, RNN_WIDTH), 0.01),
        "gate_w": nrm((L, 2, LRU_BLOCKS, LRU_BLOCK, LRU_BLOCK), LRU_BLOCK ** -0.5),
        "gate_b": nrm((L, 2, RNN_WIDTH), 0.01),
        "lru_lambda": lru_lambda,
        "w_br_a": nrm((L, DIFF_V_WIDTH, D), DIFF_V_WIDTH ** -0.5),
        "w_br_b": nrm((L, RNN_WIDTH, D), RNN_WIDTH ** -0.5),
        "w_br_c": nrm((L, DIL_WIDTH, D), DIL_WIDTH ** -0.5),
        "w_out": nrm((L, D, D), D ** -0.5 * DEEPNORM_BETA),
        "ln1_g": 1.0 + nrm((L, D), 0.02),
        "ln1_b": nrm((L, D), 0.02),
        "xq": nrm((L, D, D), D ** -0.5),
        "xkv": nrm((L, D, 2 * D), D ** -0.5),
        "xo": nrm((L, D, D), D ** -0.5 * DEEPNORM_BETA),
        "ln2_g": 1.0 + nrm((L, D), 0.02),
        "ln2_b": nrm((L, D), 0.02),
        "w_up": nrm((L, D, 2 * FFN_HIDDEN), D ** -0.5),
        "w_down": nrm((L, FFN_HIDDEN, D), FFN_HIDDEN ** -0.5 * DEEPNORM_BETA),
        "ln3_g": 1.0 + nrm((L, D), 0.02),
        "ln3_b": nrm((L, D), 0.02),
    }


def reference(x, mem, w_in, lam_qk, diff_subln, conv_w, conv_b, gate_w, gate_b, lru_lambda,
              w_br_a, w_br_b, w_br_c, w_out, ln1_g, ln1_b, xq, xkv, xo, ln2_g, ln2_b,
              w_up, w_down, ln3_g, ln3_b):
    for l in range(DEPTH):
        h = hybrid_mixer(x, l, w_in[l], lam_qk[l], diff_subln[l], conv_w[l], conv_b[l], gate_w[l],
                         gate_b[l], lru_lambda[l], w_br_a[l], w_br_b[l], w_br_c[l], w_out[l])
        x = layer_norm(DEEPNORM_ALPHA * x + h, ln1_g[l], ln1_b[l])
        x = layer_norm(DEEPNORM_ALPHA * x + memory_cross_attention(x, mem, xq[l], xkv[l], xo[l]),
                       ln2_g[l], ln2_b[l])
        x = layer_norm(DEEPNORM_ALPHA * x + swiglu(x, w_up[l], w_down[l]), ln3_g[l], ln3_b[l])
    return x
```

```cpp
#include <hip/hip_runtime.h>
#include <hip/hip_cooperative_groups.h>
#include <cstdio>
#include <cstdint>
namespace cg = cooperative_groups;

typedef unsigned short bf16_t;
typedef short bf16x8 __attribute__((ext_vector_type(8)));
typedef short s16x4 __attribute__((ext_vector_type(4)));
typedef float f32x4 __attribute__((ext_vector_type(4)));
typedef unsigned u32x4 __attribute__((ext_vector_type(4)));
typedef unsigned u32x2 __attribute__((ext_vector_type(2)));
#define LDS __attribute__((address_space(3)))
typedef LDS char lds_char;
#define DEV __device__ __forceinline__

constexpr int SEQ = 8192, NB = 8, DM = 1024, NTOK = NB * SEQ;
constexpr int SMEM_BYTES = 77824;
constexpr float ALPHA = 1.41421356237309515f;
constexpr float LOG2E = 1.44269504088896341f;
constexpr float LN2 = 0.69314718055994531f;

constexpr size_t MiB = 1048576;
constexpr size_t WL_ELEMS = 24510464;
constexpr size_t OFF_WT = 1 * MiB;
constexpr size_t OFF_MEMB = 100 * MiB;
constexpr size_t OFF_MEMKV = 964 * MiB;
constexpr size_t OFF_XB = 120 * MiB;
constexpr size_t OFF_AQ = 248 * MiB, OFF_AK = 312 * MiB, OFF_AV = 376 * MiB, OFF_RX = 440 * MiB, OFF_RG = 568 * MiB,
                 OFF_CQ = 696 * MiB, OFF_CK = 760 * MiB, OFF_CV = 824 * MiB, OFF_OC = 888 * MiB, OFF_LSE = 952 * MiB,
                 OFF_LA = 954 * MiB, OFF_LH = 958 * MiB;
constexpr size_t OFF_MERGED = OFF_RX, OFF_QX = OFF_AK, OFF_HMID = OFF_AQ;
constexpr size_t W_IN = 0, W_BRA = 8388608, W_BRB = 8912896, W_BRC = 9961472, W_OUT = 10485760, W_XQ = 11534336,
                 W_XKV = 12582912, W_XO = 14680064, W_UP = 15728640, W_DOWN = 21495808, W_GW = 24379392;

struct Params {
    const float* in[25];
    float* out;
    char* ws;
    int ph_lo, ph_hi;
};
typedef const __attribute__((address_space(4))) Params CParams;
enum { I_X = 0, I_MEM, I_WIN, I_LAMQK, I_SUBLN, I_CONVW, I_CONVB, I_GATEW, I_GATEB, I_LAMBDA, I_BRA, I_BRB, I_BRC, I_WOUT,
       I_LN1G, I_LN1B, I_XQ, I_XKV, I_XO, I_LN2G, I_LN2B, I_WUP, I_WDOWN, I_LN3G, I_LN3B };

DEV unsigned pk2(float lo, float hi) { unsigned r; asm("v_cvt_pk_bf16_f32 %0, %1, %2" : "=v"(r) : "v"(lo), "v"(hi)); return r; }
DEV float bf2f(bf16_t v) { return __uint_as_float((unsigned)v << 16); }
DEV float bflo(unsigned v) { return __uint_as_float(v << 16); }
DEV float bfhi(unsigned v) { return __uint_as_float(v & 0xffff0000u); }
DEV float fexp2(float x) { return __builtin_amdgcn_exp2f(x); }
DEV float fexp(float x) { return __builtin_amdgcn_exp2f(x * LOG2E); }
DEV float sigmoidf_(float x) { return 1.0f / (1.0f + fexp(-x)); }
DEV int tidx() { int t = __builtin_amdgcn_workitem_id_x(); asm volatile("" : "+v"(t)); return t; }
#ifndef WT_SCOPE
#define WT_SCOPE __HIP_MEMORY_SCOPE_AGENT
#endif
#ifdef DBG_PLAIN_STORES
DEV void wt_store8(void* ptr, u32x2 v) { *(u32x2*)ptr = v; }
DEV void wt_store8_unused(void* ptr, u32x2 v) { __hip_atomic_store((unsigned long long*)ptr, ((unsigned long long)v.y << 32) | v.x, __ATOMIC_RELAXED, WT_SCOPE); }
#else
DEV void wt_store8(void* ptr, u32x2 v) { __hip_atomic_store((unsigned long long*)ptr, ((unsigned long long)v.y << 32) | v.x, __ATOMIC_RELAXED, WT_SCOPE); }
#endif
DEV void wt_store4f(float* ptr, float v) { __hip_atomic_store(ptr, v, __ATOMIC_RELAXED, WT_SCOPE); }
DEV void wt_store2(bf16_t* ptr, bf16_t v) { __hip_atomic_store(ptr, v, __ATOMIC_RELAXED, WT_SCOPE); }
DEV void wt_store16(void* ptr, u32x4 v) { u32x2 a; a.x = v.x; a.y = v.y; u32x2 b; b.x = v.z; b.y = v.w; wt_store8(ptr, a); wt_store8((char*)ptr + 8, b); }
#define MFMA(a, b, c) __builtin_amdgcn_mfma_f32_16x16x32_bf16((a), (b), (c), 0, 0, 0)

DEV u32x4 coh_load16(const bf16_t* ptr) {
    const unsigned long long* q = (const unsigned long long*)ptr;
    const unsigned long long a = __hip_atomic_load(q, __ATOMIC_RELAXED, __HIP_MEMORY_SCOPE_SYSTEM);
    const unsigned long long b = __hip_atomic_load(q + 1, __ATOMIC_RELAXED, __HIP_MEMORY_SCOPE_SYSTEM);
    u32x4 r; r.x = (unsigned)a; r.y = (unsigned)(a >> 32); r.z = (unsigned)b; r.w = (unsigned)(b >> 32); return r;
}
template <int MI, bool COH>
DEV void gemm_gload(const bf16_t* A, int lda, int m0, const bf16_t* Bt, int ldb, int n0, int k0, u32x4 (&ra)[4], u32x4 (&rb)[MI]) {
    const int T = tidx();
#pragma unroll
    for (int i = 0; i < 4; ++i) {
        const int q = i * 256 + T, r = q >> 3, lc = (q & 7) ^ (r & 7);
        if (COH) {
#ifdef DBG_XQ_F32
            { const float* Af = (const float*)A + (size_t)(m0 + r) * lda + k0 + lc * 8; const f32x4 v0 = *(const f32x4*)Af, v1 = *(const f32x4*)(Af + 4); u32x4 t; t.x = pk2(v0[0], v0[1]); t.y = pk2(v0[2], v0[3]); t.z = pk2(v1[0], v1[1]); t.w = pk2(v1[2], v1[3]); ra[i] = t; }
            if (i < MI) rb[i] = *(const u32x4*)(Bt + (size_t)(n0 + r) * ldb + k0 + lc * 8);
            continue;
#endif
            ra[i] = coh_load16(A + (size_t)(m0 + r) * lda + k0 + lc * 8);
            if (i < MI) rb[i] = coh_load16(Bt + (size_t)(n0 + r) * ldb + k0 + lc * 8);
        } else {
            ra[i] = *(const u32x4*)(A + (size_t)(m0 + r) * lda + k0 + lc * 8);
            if (i < MI) rb[i] = *(const u32x4*)(Bt + (size_t)(n0 + r) * ldb + k0 + lc * 8);
        }
    }
}
template <int MI>
DEV void gemm_sstore(lds_char* st, const u32x4 (&ra)[4], const u32x4 (&rb)[MI]) {
    const int T = tidx();
#pragma unroll
    for (int i = 0; i < 4; ++i) {
        const int q = i * 256 + T;
        *(LDS u32x4*)(st + q * 16) = ra[i];
        if (i < MI) *(LDS u32x4*)(st + 16384 + q * 16) = rb[i];
    }
}
template <int MI, bool COH = false>
DEV void gemm_acc(f32x4 (&acc)[MI][4], const bf16_t* A, int lda, int m0, const bf16_t* Bt, int ldb, int n0, int K, lds_char* smem) {
    constexpr int WN = MI / 2;
    const int T = tidx(), lane = T & 63, w = T >> 6, wr = w / WN, wc = w % WN, fr = lane & 15, fq = lane >> 4;
    const int nt = K >> 6;
    u32x4 ra[4], rb[MI];
    gemm_gload<MI, COH>(A, lda, m0, Bt, ldb, n0, 0, ra, rb);
    __syncthreads();
    for (int t = 0; t < nt; ++t) {
        lds_char* a = smem + (t & 1) * 32768;
        lds_char* b = a + 16384;
        gemm_sstore<MI>(a, ra, rb);
        __syncthreads();
        if (t + 1 < nt) gemm_gload<MI, COH>(A, lda, m0, Bt, ldb, n0, (t + 1) * 64, ra, rb);
#pragma unroll
        for (int ks = 0; ks < 2; ++ks) {
            bf16x8 af[MI], bfr[4];
#pragma unroll
            for (int m = 0; m < MI; ++m) { const int r = wr * (MI * 16) + m * 16 + fr; af[m] = *(const LDS bf16x8*)(a + r * 128 + (((ks * 4 + fq) ^ (r & 7)) << 4)); }
#pragma unroll
            for (int n = 0; n < 4; ++n) { const int r = wc * 64 + n * 16 + fr; bfr[n] = *(const LDS bf16x8*)(b + r * 128 + (((ks * 4 + fq) ^ (r & 7)) << 4)); }
#pragma unroll
            for (int m = 0; m < MI; ++m)
#pragma unroll
                for (int n = 0; n < 4; ++n) acc[m][n] = MFMA(bfr[n], af[m], acc[m][n]);
        }
    }
}
template <int MI>
DEV void zero_acc(f32x4 (&acc)[MI][4]) {
#pragma unroll
    for (int m = 0; m < MI; ++m)
#pragma unroll
        for (int n = 0; n < 4; ++n) acc[m][n] = (f32x4){0.f, 0.f, 0.f, 0.f};
}
#define GEMM_IDS_(MI) const int T = tidx(), lane = T & 63, w = T >> 6, wr = w / ((MI) / 2), wc = w % ((MI) / 2), fr = lane & 15, fq = lane >> 4; constexpr int MI_ = (MI); (void)T; (void)lane; (void)w
#define GEMM_IDS GEMM_IDS_(4)
#define CROW(m) (m0 + wr * (MI_ * 16) + (m) * 16 + fr)
#define CCOL(n) (n0 + wc * 64 + (n) * 16 + fq * 4)

template <int MI>
DEV void epi_bf16(const f32x4 (&acc)[MI][4], bf16_t* dst, int ld, int m0, int n0) {
    GEMM_IDS_(MI);
    float one = 1.0f; asm volatile("" : "+v"(one));
#pragma unroll
    for (int m = 0; m < MI; ++m)
#pragma unroll
        for (int n = 0; n < 4; ++n) {
            const f32x4 a = acc[m][n] * one;
            u32x2 v; v.x = pk2(a[0], a[1]); v.y = pk2(a[2], a[3]);
            wt_store8(dst + (size_t)CROW(m) * ld + CCOL(n), v);
        }
}
DEV void epi_res(const f32x4 (&acc)[4][4], const float* res, float* out, int m0, int n0) {
    GEMM_IDS;
#pragma unroll
    for (int m = 0; m < 4; ++m)
#pragma unroll
        for (int n = 0; n < 4; ++n) {
            const size_t o = (size_t)CROW(m) * DM + CCOL(n);
            const f32x4 r = *(const f32x4*)(res + o);
            { f32x4 a = acc[m][n];
#ifdef DBG_SANITIZE
              for (int e = 0; e < 4; ++e) if (!(fabsf(a[e]) < 1e30f)) a[e] = 0.f;
#endif
              const f32x4 y = r * ALPHA + a; wt_store16(out + o, __builtin_bit_cast(u32x4, y)); }
        }
}

DEV void transpose_tile(const float* __restrict__ src, int N, bf16_t* __restrict__ dst, int K, int k0, int n0, lds_char* smem) {
    LDS float* t = (LDS float*)smem;
    const int T = tidx();
    __syncthreads();
#pragma unroll
    for (int i = 0; i < 4; ++i) {
        const int q = i * 256 + T, r = q >> 4, c = (q & 15) * 4;
        const f32x4 v = *(const f32x4*)(src + (size_t)(k0 + r) * N + n0 + c);
        t[r * 65 + c] = v[0]; t[r * 65 + c + 1] = v[1]; t[r * 65 + c + 2] = v[2]; t[r * 65 + c + 3] = v[3];
    }
    __syncthreads();
#pragma unroll
    for (int i = 0; i < 2; ++i) {
        const int q = i * 256 + T, rr = q >> 3, cc = (q & 7) * 8;
        u32x4 v;
        v.x = pk2(t[(cc + 0) * 65 + rr], t[(cc + 1) * 65 + rr]); v.y = pk2(t[(cc + 2) * 65 + rr], t[(cc + 3) * 65 + rr]);
        v.z = pk2(t[(cc + 4) * 65 + rr], t[(cc + 5) * 65 + rr]); v.w = pk2(t[(cc + 6) * 65 + rr], t[(cc + 7) * 65 + rr]);
        wt_store16(dst + (size_t)(n0 + rr) * K + k0 + cc, v);
    }
}
DEV void phase_prep(CParams& p, lds_char* smem) {
    const int G = gridDim.x, bid = blockIdx.x, T = tidx();
    bf16_t* WT = (bf16_t*)(p.ws + OFF_WT);
    for (int u = bid; u < 2 * 5984; u += G) {
        const int l = u / 5984; int t = u % 5984;
        const float* src; size_t doff; int K, N;
        if (t < 2048) { src = p.in[I_WIN] + (size_t)l * 1024 * 8192; doff = W_IN; K = 1024; N = 8192; }
        else if ((t -= 2048) < 128) { src = p.in[I_BRA] + (size_t)l * 512 * 1024; doff = W_BRA; K = 512; N = 1024; }
        else if ((t -= 128) < 256) { src = p.in[I_BRB] + (size_t)l * 1024 * 1024; doff = W_BRB; K = 1024; N = 1024; }
        else if ((t -= 256) < 128) { src = p.in[I_BRC] + (size_t)l * 512 * 1024; doff = W_BRC; K = 512; N = 1024; }
        else if ((t -= 128) < 256) { src = p.in[I_WOUT] + (size_t)l * 1024 * 1024; doff = W_OUT; K = 1024; N = 1024; }
        else if ((t -= 256) < 256) { src = p.in[I_XQ] + (size_t)l * 1024 * 1024; doff = W_XQ; K = 1024; N = 1024; }
        else if ((t -= 256) < 512) { src = p.in[I_XKV] + (size_t)l * 1024 * 2048; doff = W_XKV; K = 1024; N = 2048; }
        else if ((t -= 512) < 256) { src = p.in[I_XO] + (size_t)l * 1024 * 1024; doff = W_XO; K = 1024; N = 1024; }
        else if ((t -= 256) < 1408) { src = p.in[I_WUP] + (size_t)l * 1024 * 5632; doff = W_UP; K = 1024; N = 5632; }
        else if ((t -= 1408) < 704) { src = p.in[I_WDOWN] + (size_t)l * 2816 * 1024; doff = W_DOWN; K = 2816; N = 1024; }
        else { t -= 704; src = p.in[I_GATEW] + (size_t)l * 131072 + (size_t)t * 4096; doff = W_GW + (size_t)t * 4096; K = 64; N = 64; t = 0; }
        const int tn = N >> 6;
        transpose_tile(src, N, WT + (size_t)l * WL_ELEMS + doff, K, (t / tn) * 64, (t % tn) * 64, smem);
    }
    {
        const f32x4* x4 = (const f32x4*)p.in[I_X]; u32x2* xb = (u32x2*)(p.ws + OFF_XB);
        for (size_t i = (size_t)bid * 256 + T; i < (size_t)NTOK * DM / 4; i += (size_t)G * 256) { const f32x4 v = x4[i]; u32x2 o; o.x = pk2(v[0], v[1]); o.y = pk2(v[2], v[3]); wt_store8(&xb[i], o); }
        const f32x4* m4 = (const f32x4*)p.in[I_MEM]; u32x2* mb = (u32x2*)(p.ws + OFF_MEMB);
        for (size_t i = (size_t)bid * 256 + T; i < (size_t)2048 * DM / 4; i += (size_t)G * 256) { const f32x4 v = m4[i]; u32x2 o; o.x = pk2(v[0], v[1]); o.y = pk2(v[2], v[3]); wt_store8(&mb[i], o); }
    }
}

DEV void rot_coef(int pos, float invf, float& c, float& s) {
    const float ang = (float)pos * invf;
    const float n = rintf(ang * 0.15915494309189535f);
    float r = fmaf(-n, 6.2831854820251465f, ang);
    r = fmaf(-n, -1.7484556025237907e-07f, r);
    c = __cosf(r); s = __sinf(r);
}
DEV void phase_u(CParams& p, int l, lds_char* smem) {
    const int G = gridDim.x, bid = blockIdx.x;
    const bf16_t* xb = (const bf16_t*)(p.ws + OFF_XB);
    const bf16_t* WT = (const bf16_t*)(p.ws + OFF_WT) + (size_t)l * WL_ELEMS;
    const int nkv = 0;
#ifdef DBG_U_XQ
    const int nu = 512 * 48 + nkv;
#else
    const int nu = 512 * 40 + nkv;
#endif
    for (int uu = bid; uu < nu; uu += G) {
        f32x4 acc[4][4]; zero_acc<4>(acc);
        if (uu < nkv) {
            const int v = uu, ll = v >> 8, t = v & 255, m0 = (t >> 4) * 128, n0 = (t & 15) * 128;
            gemm_acc<4, false>(acc, (const bf16_t*)(p.ws + OFF_MEMB), 1024, m0, (const bf16_t*)(p.ws + OFF_WT) + (size_t)ll * WL_ELEMS + W_XKV, 1024, n0, 1024, smem);
            epi_bf16<4>(acc, (bf16_t*)(p.ws + OFF_MEMKV) + (size_t)ll * 2048 * 2048, 2048, m0, n0);
            continue;
        }
        const int u = uu - nkv;
#ifdef DBG_U_XQ
        const int m0 = (u / 48) * 128, n0 = (u % 48) * 128;
        gemm_acc<4>(acc, xb, 1024, m0, (n0 < 5120) ? (WT + W_IN) : (WT + (W_XQ - (size_t)5120 * 1024)), 1024, n0, 1024, smem);
        if (n0 >= 5120) { if (m0 < 16384) epi_bf16<4>(acc, (bf16_t*)(p.ws + 984 * MiB), 1024, m0, n0 - 5120); continue; }
#else
        const int m0 = (u / 40) * 128, n0 = (u % 40) * 128;
        gemm_acc<4>(acc, xb, 1024, m0, WT + W_IN, 1024, n0, 1024, smem);
#endif
        bf16_t* dst; int ld, c0; bool rot = false;
        if (n0 < 512) { dst = (bf16_t*)(p.ws + OFF_AQ); ld = 512; c0 = n0; rot = true; }
        else if (n0 < 1024) { dst = (bf16_t*)(p.ws + OFF_AK); ld = 512; c0 = n0 - 512; rot = true; }
        else if (n0 < 1536) { dst = (bf16_t*)(p.ws + OFF_AV); ld = 512; c0 = n0 - 1024; }
        else if (n0 < 2560) { dst = (bf16_t*)(p.ws + OFF_RX); ld = 1024; c0 = n0 - 1536; }
        else if (n0 < 3584) { dst = (bf16_t*)(p.ws + OFF_RG); ld = 1024; c0 = n0 - 2560; }
        else if (n0 < 4096) { dst = (bf16_t*)(p.ws + OFF_CQ); ld = 512; c0 = n0 - 3584; rot = true; }
        else if (n0 < 4608) { dst = (bf16_t*)(p.ws + OFF_CK); ld = 512; c0 = n0 - 4096; rot = true; }
        else { dst = (bf16_t*)(p.ws + OFF_CV); ld = 512; c0 = n0 - 4608; }
        GEMM_IDS;
        if (rot) {
            const bool hi = (fq & 2) != 0, odd = (fq & 1) != 0;
            const float f0 = odd ? 0.001414213562373095f : 1.0f, f1 = odd ? 0.0002742481756762073f : 0.19392274474868576f,
                        f2 = odd ? 5.318295896944988e-05f : 0.03760603093086393f, f3 = odd ? 1.031338537721246e-05f : 0.007292664737217109f;
#pragma unroll
            for (int m = 0; m < 4; ++m) {
                const int pos = CROW(m) & (SEQ - 1);
                f32x4 v = acc[m][0], o;
#pragma unroll
                for (int j = 0; j < 4; ++j) {
                    const float pv = __shfl_xor(v[j], 32);
                    float c, s; rot_coef(pos, j == 0 ? f0 : j == 1 ? f1 : j == 2 ? f2 : f3, c, s);
                    o[j] = hi ? (v[j] * c + pv * s) : (v[j] * c - pv * s);
                }
                acc[m][0] = o;
            }
        }
        epi_bf16<4>(acc, dst, ld, m0, c0);
    }
}

template <int D, int DV, int KW, int MT, int MODE, bool PF>
DEV void flash_core(const bf16_t* __restrict__ Qp, int ldq, int qtok0, int qstride, int qrow0,
                    const bf16_t* __restrict__ Kp, int ldk, const bf16_t* __restrict__ Vp, int ldv, int ktok0, int kstride,
                    int kt_begin, int kt_end, int koff, float sc, int qpos0, lds_char* smem,
                    f32x4 (&o)[MT][DV / 16], float (&mrow)[MT], float (&lrow)[MT]) {
    const int T = tidx(), lane = T & 63, fr = lane & 15, fq = lane >> 4;
    constexpr int KSTR = KW * 2 + 16, VSTR = DV * 2 + 32;
    lds_char* Ks = smem;
    lds_char* Vs = smem + 64 * KSTR;
    constexpr int KCH = KW / 8, NKL = 64 * KCH / 256, VCH = DV / 8, NVL = 64 * VCH / 256;
    bf16x8 qf[MT][D / 32];
#pragma unroll
    for (int mt = 0; mt < MT; ++mt)
#pragma unroll
        for (int ks = 0; ks < D / 32; ++ks)
            qf[mt][ks] = *(const bf16x8*)(Qp + (size_t)(qtok0 + (qrow0 + mt * 16 + fr) * qstride) * ldq + ks * 32 + fq * 8);
#pragma unroll
    for (int mt = 0; mt < MT; ++mt) {
        mrow[mt] = -1e30f; lrow[mt] = 0.f;
#pragma unroll
        for (int dt = 0; dt < DV / 16; ++dt) o[mt][dt] = (f32x4){0.f, 0.f, 0.f, 0.f};
    }
    u32x4 kreg[NKL], vreg[NVL];
    if (PF && kt_begin < kt_end) {
#pragma unroll
        for (int i = 0; i < NKL; ++i) { const int q = i * 256 + T, row = q / KCH, ch = q % KCH; kreg[i] = *(const u32x4*)(Kp + (size_t)(ktok0 + (kt_begin * 64 + row) * kstride) * ldk + ch * 8); }
#pragma unroll
        for (int i = 0; i < NVL; ++i) { const int q = i * 256 + T, row = q / VCH, ch = q % VCH; vreg[i] = *(const u32x4*)(Vp + (size_t)(ktok0 + (kt_begin * 64 + row) * kstride) * ldv + ch * 8); }
    }
    const int vbase = (4 * fq + ((lane >> 2) & 3)) * VSTR + (lane & 3) * 8;
    for (int kt = kt_begin; kt < kt_end; ++kt) {
        if (!PF) {
#pragma unroll
            for (int i = 0; i < NKL; ++i) { const int q = i * 256 + T, row = q / KCH, ch = q % KCH; kreg[i] = *(const u32x4*)(Kp + (size_t)(ktok0 + (kt * 64 + row) * kstride) * ldk + ch * 8); }
#pragma unroll
            for (int i = 0; i < NVL; ++i) { const int q = i * 256 + T, row = q / VCH, ch = q % VCH; vreg[i] = *(const u32x4*)(Vp + (size_t)(ktok0 + (kt * 64 + row) * kstride) * ldv + ch * 8); }
        }
        __syncthreads();
#pragma unroll
        for (int i = 0; i < NKL; ++i) { const int q = i * 256 + T, row = q / KCH, ch = q % KCH; *(LDS u32x4*)(Ks + row * KSTR + ch * 16) = kreg[i]; }
#pragma unroll
        for (int i = 0; i < NVL; ++i) { const int q = i * 256 + T, row = q / VCH, ch = q % VCH; *(LDS u32x4*)(Vs + row * VSTR + ch * 16) = vreg[i]; }
        __syncthreads();
        if (PF && kt + 1 < kt_end) {
#pragma unroll
            for (int i = 0; i < NKL; ++i) { const int q = i * 256 + T, row = q / KCH, ch = q % KCH; kreg[i] = *(const u32x4*)(Kp + (size_t)(ktok0 + ((kt + 1) * 64 + row) * kstride) * ldk + ch * 8); }
#pragma unroll
            for (int i = 0; i < NVL; ++i) { const int q = i * 256 + T, row = q / VCH, ch = q % VCH; vreg[i] = *(const u32x4*)(Vp + (size_t)(ktok0 + ((kt + 1) * 64 + row) * kstride) * ldv + ch * 8); }
        }
        bool act = true;
        if (MODE == 1) act = (64 * kt + 63 >= qrow0) && (64 * kt <= qrow0 + MT * 16 - 1 + 128);
        if (act) {
            const bool domask = (MODE == 0) ? (kt == kt_end - 1) : (MODE == 1);
            bf16x8 pf[MT][2];
#pragma unroll
            for (int mt = 0; mt < MT; ++mt) {
                f32x4 s[4];
#pragma unroll
                for (int n = 0; n < 4; ++n) s[n] = (f32x4){0.f, 0.f, 0.f, 0.f};
#pragma unroll
                for (int ks = 0; ks < D / 32; ++ks) {
#pragma unroll
                    for (int n = 0; n < 4; ++n) {
                        const bf16x8 kf = *(const LDS bf16x8*)(Ks + (n * 16 + fr) * KSTR + (koff + ks * 32 + fq * 8) * 2);
                        s[n] = MFMA(kf, qf[mt][ks], s[n]);
                    }
                }
                const int qi = qrow0 + mt * 16 + fr;
                float mx = -INFINITY;
#pragma unroll
                for (int n = 0; n < 4; ++n)
#pragma unroll
                    for (int j = 0; j < 4; ++j) {
                        float v = s[n][j] * sc;
                        if (domask) {
                            const int kj = kt * 64 + n * 16 + fq * 4 + j;
                            bool ok;
                            if (MODE == 0) ok = kj <= qpos0 + qi; else ok = (kj >= qi) && (kj <= qi + 128);
                            if (!ok) v = -INFINITY;
                        }
                        s[n][j] = v; mx = fmaxf(mx, v);
                    }
                mx = fmaxf(mx, __shfl_xor(mx, 16)); mx = fmaxf(mx, __shfl_xor(mx, 32));
                const float mn = fmaxf(mrow[mt], mx);
                const float alpha = fexp2(mrow[mt] - mn);
                mrow[mt] = mn;
                float rs = 0.f;
#pragma unroll
                for (int n = 0; n < 4; ++n)
#pragma unroll
                    for (int j = 0; j < 4; ++j) { const float pe = fexp2(s[n][j] - mn); s[n][j] = pe; rs += pe; }
                lrow[mt] = lrow[mt] * alpha + rs;
#pragma unroll
                for (int dt = 0; dt < DV / 16; ++dt) o[mt][dt] *= alpha;
#pragma unroll
                for (int k2 = 0; k2 < 2; ++k2) {
                    u32x4 t;
                    t.x = pk2(s[2 * k2][0], s[2 * k2][1]); t.y = pk2(s[2 * k2][2], s[2 * k2][3]);
                    t.z = pk2(s[2 * k2 + 1][0], s[2 * k2 + 1][1]); t.w = pk2(s[2 * k2 + 1][2], s[2 * k2 + 1][3]);
                    pf[mt][k2] = __builtin_bit_cast(bf16x8, t);
                }
            }
#pragma unroll
            for (int k2 = 0; k2 < 2; ++k2)
#pragma unroll
                for (int dt = 0; dt < DV / 16; ++dt) {
                    const s16x4 v0 = __builtin_amdgcn_ds_read_tr16_b64_v4i16((LDS s16x4*)(Vs + vbase + (k2 * 32) * VSTR + dt * 32));
                    const s16x4 v1 = __builtin_amdgcn_ds_read_tr16_b64_v4i16((LDS s16x4*)(Vs + vbase + (k2 * 32 + 16) * VSTR + dt * 32));
                    const bf16x8 vf = __builtin_shufflevector(v0, v1, 0, 1, 2, 3, 4, 5, 6, 7);
#pragma unroll
                    for (int mt = 0; mt < MT; ++mt) o[mt][dt] = MFMA(vf, pf[mt][k2], o[mt][dt]);
                }
        }
    }
}

DEV void diff_unit(CParams& p, int l, int unit, lds_char* smem) {
    const int T = tidx(), lane = T & 63, w = T >> 6, fr = lane & 15, fq = lane >> 4;
    const int qt = 127 - (unit >> 5), bh = unit & 31, b = bh >> 2, h = bh & 3;
    const int comp = w >> 1, qrow0 = (w & 1) * 32;
    f32x4 o[2][8]; float mrow[2], lrow[2];
    bf16_t* aq = (bf16_t*)(p.ws + OFF_AQ);
    flash_core<64, 128, 128, 2, 0, false>(aq + h * 128 + comp * 64, 512, b * SEQ + qt * 64, 1, qrow0,
                                   (const bf16_t*)(p.ws + OFF_AK) + h * 128, 512, (const bf16_t*)(p.ws + OFF_AV) + h * 128, 512, b * SEQ, 1,
                                   0, qt + 1, comp * 64, 0.125f * LOG2E, qt * 64, smem, o, mrow, lrow);
    int l2 = l; asm volatile("" : "+s"(l2));
    const float linit = (l2 == 0) ? 0.2f : 0.35550906759096934f;
    float lam;
    {
        const float* lq = p.in[I_LAMQK] + l2 * 256;
        float s1 = lq[lane] * lq[64 + lane], s2 = lq[128 + lane] * lq[192 + lane];
#pragma unroll
        for (int o = 32; o >= 1; o >>= 1) { s1 += __shfl_xor(s1, o); s2 += __shfl_xor(s2, o); }
        lam = expf(s1) - expf(s2) + linit;
    }
#pragma unroll
    for (int mt = 0; mt < 2; ++mt) {
        float lt = lrow[mt]; lt += __shfl_xor(lt, 16); lt += __shfl_xor(lt, 32);
        const float inv = 1.0f / lt;
#pragma unroll
        for (int dt = 0; dt < 8; ++dt) o[mt][dt] *= inv;
    }
    __syncthreads();
    LDS float* X = (LDS float*)smem;
    if (comp == 1) {
#pragma unroll
        for (int mt = 0; mt < 2; ++mt)
#pragma unroll
            for (int dt = 0; dt < 8; ++dt) *(LDS f32x4*)(X + ((w & 1) * 32 + mt * 16 + fr) * 132 + dt * 16 + fq * 4) = o[mt][dt];
    }
    __syncthreads();
    if (comp == 0) {
        const float* g = p.in[I_SUBLN] + l * 128;
#pragma unroll
        for (int mt = 0; mt < 2; ++mt) {
            float ss = 0.f;
#pragma unroll
            for (int dt = 0; dt < 8; ++dt) {
                const f32x4 o2 = *(const LDS f32x4*)(X + ((w & 1) * 32 + mt * 16 + fr) * 132 + dt * 16 + fq * 4);
                o[mt][dt] = o[mt][dt] - lam * o2;
                ss += o[mt][dt][0] * o[mt][dt][0] + o[mt][dt][1] * o[mt][dt][1] + o[mt][dt][2] * o[mt][dt][2] + o[mt][dt][3] * o[mt][dt][3];
            }
            ss += __shfl_xor(ss, 16); ss += __shfl_xor(ss, 32);
            const float r = rsqrtf(ss * (1.0f / 128.0f) + 1e-5f) * (1.0f - linit);
            bf16_t* dst = aq + (size_t)(b * SEQ + qt * 64 + qrow0 + mt * 16 + fr) * 512 + h * 128 + fq * 4;
#pragma unroll
            for (int dt = 0; dt < 8; ++dt) {
                const f32x4 gg = *(const f32x4*)(g + dt * 16 + fq * 4);
                u32x2 v; v.x = pk2(o[mt][dt][0] * r * gg[0], o[mt][dt][1] * r * gg[1]); v.y = pk2(o[mt][dt][2] * r * gg[2], o[mt][dt][3] * r * gg[3]);
                wt_store8(dst + dt * 16, v);
            }
        }
    }
}

DEV void dil_unit(CParams& p, int pat, int unit, lds_char* smem) {
    const int T = tidx(), lane = T & 63, w = T >> 6, fr = lane & 15, fq = lane >> 4;
    const int dil = (pat == 0) ? 1 : (pat == 1) ? 4 : 16;
    const int bh = unit & 63, b = bh >> 3, head = bh & 7, pn = unit >> 6, ph = pn % dil, n = pn / dil;
    const int qrow0 = w * 32;
    f32x4 o[2][4]; float mrow[2], lrow[2];
    const int qtok0 = b * SEQ + n * 128 * dil + ph, ktok0 = b * SEQ + (n - 1) * 128 * dil + ph;
    flash_core<64, 64, 64, 2, 1, true>((const bf16_t*)(p.ws + OFF_CQ) + head * 64, 512, qtok0, dil, qrow0,
                                 (const bf16_t*)(p.ws + OFF_CK) + head * 64, 512, (const bf16_t*)(p.ws + OFF_CV) + head * 64, 512, ktok0, dil,
                                 (n == 0) ? 2 : 0, 4, 0, 0.125f * LOG2E, 0, smem, o, mrow, lrow);
    bf16_t* oc = (bf16_t*)(p.ws + OFF_OC);
    float* lsebuf = (float*)(p.ws + OFF_LSE);
#pragma unroll
    for (int mt = 0; mt < 2; ++mt) {
        float lt = lrow[mt]; lt += __shfl_xor(lt, 16); lt += __shfl_xor(lt, 32);
        const float inv = 1.0f / lt;
        float lse = (mrow[mt] + log2f(lt)) * LN2;
        const size_t tok = (size_t)qtok0 + (size_t)(qrow0 + mt * 16 + fr) * dil;
        bf16_t* dst = oc + tok * 512 + head * 64 + fq * 4;
        float wn = inv, wo = 0.f;
        if (pat > 0) {
            const float lo = lsebuf[tok * 8 + head];
            const float mxl = fmaxf(lo, lse);
            const float eo = fexp(lo - mxl), en = fexp(lse - mxl);
            const float tot = eo + en;
            wo = eo / tot; wn = inv * en / tot;
            lse = mxl + logf(tot);
        }
#pragma unroll
        for (int dt = 0; dt < 4; ++dt) {
            f32x4 v = o[mt][dt] * wn;
            if (pat > 0) { const u32x2 old = *(const u32x2*)(dst + dt * 16); v[0] += wo * bflo(old.x); v[1] += wo * bfhi(old.x); v[2] += wo * bflo(old.y); v[3] += wo * bfhi(old.y); }
            u32x2 r; r.x = pk2(v[0], v[1]); r.y = pk2(v[2], v[3]);
            wt_store8(dst + dt * 16, r);
        }
        if (pat < 2 && fq == 0) wt_store4f(&lsebuf[tok * 8 + head], lse);
    }
}

DEV void xattn_unit(CParams& p, int l, int unit, lds_char* smem) {
    const int T = tidx(), lane = T & 63, w = T >> 6, fr = lane & 15, fq = lane >> 4;
    const int h = unit & 3, tok0 = (unit >> 2) * 64, b = tok0 / SEQ;
    f32x4 o[1][16]; float mrow[1], lrow[1];
    bf16_t* qx = (bf16_t*)(p.ws + OFF_QX);
    const bf16_t* kv = (const bf16_t*)(p.ws + OFF_MEMKV) + (size_t)l * 2048 * 2048;
    flash_core<256, 256, 256, 1, 2, false>(qx + h * 256, 1024, tok0, 1, w * 16, kv + h * 256, 2048, kv + 1024 + h * 256, 2048, b * 256, 1,
                                    0, 4, 0, 0.0625f * LOG2E, 0, smem, o, mrow, lrow);
    float lt = lrow[0]; lt += __shfl_xor(lt, 16); lt += __shfl_xor(lt, 32);
    const float inv = 1.0f / lt;
    bf16_t* dst = qx + (size_t)(tok0 + w * 16 + fr) * 1024 + h * 256 + fq * 4;
#pragma unroll
    for (int dt = 0; dt < 16; ++dt) {
        u32x2 r; r.x = pk2(o[0][dt][0] * inv, o[0][dt][1] * inv); r.y = pk2(o[0][dt][2] * inv, o[0][dt][3] * inv);
        wt_store8(dst + dt * 16, r);
    }
}

DEV float neg_expm1(float x) {
    if (x > -0.3f) { float r = 1.0f / 720.0f; r = r * x + 1.0f / 120.0f; r = r * x + 1.0f / 24.0f; r = r * x + 1.0f / 6.0f; r = r * x + 0.5f; r = r * x + 1.0f; return -(r * x); }
    return 1.0f - fexp(x);
}
DEV float gelu_tanh(float x) {
    const float y = 0.7978845608028654f * (x + 0.044715f * x * x * x);
    const float t = 1.0f - 2.0f / (fexp(2.0f * y) + 1.0f);
    return 0.5f * x * (1.0f + t);
}
DEV void lru_unit(CParams& p, int l, int unit, int pass, lds_char* smem) {
    const int T = tidx(), lane = T & 63, w = T >> 6, fr = lane & 15, fq = lane >> 4;
    const int grp = unit & 3, c = (unit >> 2) & 127, b = unit >> 9;
    const int nb = grp * 4 + w, ch0 = nb * 64;
    lds_char* Xs = smem + w * 19456;
    lds_char* XCs = Xs + 9728;
    const bf16_t* rx = (const bf16_t*)(p.ws + OFF_RX);
    bf16_t* rg = (bf16_t*)(p.ws + OFF_RG);
    __syncthreads();
    for (int q = lane; q < 536; q += 64) {
        const int r = q >> 3, ch = q & 7, s = c * 64 + r - 3;
        u32x4 v = (u32x4){0u, 0u, 0u, 0u};
        if (s >= 0) v = *(const u32x4*)(rx + ((size_t)b * SEQ + s) * 1024 + ch0 + ch * 8);
        *(LDS u32x4*)(Xs + r * 144 + ch * 16) = v;
    }
    __syncthreads();
    {
        const int ch = lane & 7;
        const float* cw = p.in[I_CONVW] + (size_t)l * 4096 + ch0 + ch * 8;
        const float* cb = p.in[I_CONVB] + (size_t)l * 1024 + ch0 + ch * 8;
        float wv[4][8], bv[8];
#pragma unroll
        for (int e = 0; e < 8; ++e) { bv[e] = cb[e];
#pragma unroll
            for (int tp = 0; tp < 4; ++tp) wv[tp][e] = cw[tp * 1024 + e]; }
#pragma unroll
        for (int it = 0; it < 8; ++it) {
            const int t = it * 8 + (lane >> 3);
            float a[8];
#pragma unroll
            for (int e = 0; e < 8; ++e) a[e] = bv[e];
#pragma unroll
            for (int tp = 0; tp < 4; ++tp) {
                const u32x4 xv = *(const LDS u32x4*)(Xs + (t + tp) * 144 + ch * 16);
                a[0] += bflo(xv.x) * wv[tp][0]; a[1] += bfhi(xv.x) * wv[tp][1]; a[2] += bflo(xv.y) * wv[tp][2]; a[3] += bfhi(xv.y) * wv[tp][3];
                a[4] += bflo(xv.z) * wv[tp][4]; a[5] += bfhi(xv.z) * wv[tp][5]; a[6] += bflo(xv.w) * wv[tp][6]; a[7] += bfhi(xv.w) * wv[tp][7];
            }
            u32x4 ov; ov.x = pk2(a[0], a[1]); ov.y = pk2(a[2], a[3]); ov.z = pk2(a[4], a[5]); ov.w = pk2(a[6], a[7]);
            *(LDS u32x4*)(XCs + t * 144 + ch * 16) = ov;
        }
    }
    __syncthreads();
    const bf16_t* gw = (const bf16_t*)(p.ws + OFF_WT) + (size_t)l * WL_ELEMS + W_GW;
    bf16x8 gf[2][4][2];
#pragma unroll
    for (int g = 0; g < 2; ++g)
#pragma unroll
        for (int nt = 0; nt < 4; ++nt)
#pragma unroll
            for (int ks = 0; ks < 2; ++ks) gf[g][nt][ks] = *(const bf16x8*)(gw + ((size_t)(g * 16 + nb) * 64 + nt * 16 + fr) * 64 + ks * 32 + fq * 8);
    float sp[4], gb0[4], gb1[4], hin[4], atot[4];
#pragma unroll
    for (int nt = 0; nt < 4; ++nt) {
        const int ch = ch0 + nt * 16 + fr;
        const float lam = p.in[I_LAMBDA][l * 1024 + ch];
        const float x = fexp(-lam);
        sp[nt] = (x < 0.03f) ? x * (1.0f + x * (-0.5f + x * (1.0f / 3.0f + x * (-0.25f + x * 0.2f)))) : logf(1.0f + x);
        gb0[nt] = p.in[I_GATEB][l * 2048 + ch]; gb1[nt] = p.in[I_GATEB][l * 2048 + 1024 + ch];
        atot[nt] = 1.0f;
        hin[nt] = (pass == 1) ? ((const float*)(p.ws + OFF_LH))[((size_t)b * 128 + c) * 1024 + ch] : 0.0f;
    }
    for (int m = 0; m < 4; ++m) {
        f32x4 ar[4], ai[4];
#pragma unroll
        for (int nt = 0; nt < 4; ++nt) { ar[nt] = (f32x4){0.f, 0.f, 0.f, 0.f}; ai[nt] = (f32x4){0.f, 0.f, 0.f, 0.f}; }
#pragma unroll
        for (int ks = 0; ks < 2; ++ks) {
            const bf16x8 xa = *(const LDS bf16x8*)(XCs + (m * 16 + fr) * 144 + (ks * 32 + fq * 8) * 2);
#pragma unroll
            for (int nt = 0; nt < 4; ++nt) { ar[nt] = MFMA(xa, gf[0][nt][ks], ar[nt]); ai[nt] = MFMA(xa, gf[1][nt][ks], ai[nt]); }
        }
#pragma unroll
        for (int nt = 0; nt < 4; ++nt) {
            float Pj[4], Hj[4]; float P = 1.0f, Hh = 0.0f;
#pragma unroll
            for (int j = 0; j < 4; ++j) {
                const int tk = m * 16 + fq * 4 + j;
                const float xc = bf2f(*(const LDS bf16_t*)(XCs + tk * 144 + (nt * 16 + fr) * 2));
                const float r = sigmoidf_(ar[nt][j] + gb0[nt]), ig = sigmoidf_(ai[nt][j] + gb1[nt]);
                const float la = -8.0f * r * sp[nt];
                const float a = fexp(la);
                const float u = sqrtf(neg_expm1(2.0f * la)) * (ig * xc);
                Hh = a * Hh + u; P *= a; Pj[j] = P; Hj[j] = Hh;
            }
            float A1 = P, H1 = Hh;
            { const float ta = __shfl_up(A1, 16), th = __shfl_up(H1, 16); if (fq >= 1) { H1 = A1 * th + H1; A1 = A1 * ta; } }
            { const float ta = __shfl_up(A1, 32), th = __shfl_up(H1, 32); if (fq >= 2) { H1 = A1 * th + H1; A1 = A1 * ta; } }
            float Ea = __shfl_up(A1, 16), Eh = __shfl_up(H1, 16);
            if (fq == 0) { Ea = 1.0f; Eh = 0.0f; }
            const float Ta = __shfl(A1, 48 + fr), Th = __shfl(H1, 48 + fr);
            if (pass == 1) {
                const float h0 = Ea * hin[nt] + Eh;
#pragma unroll
                for (int j = 0; j < 4; ++j) {
                    const int tk = m * 16 + fq * 4 + j;
                    const float hv = Pj[j] * h0 + Hj[j];
                    bf16_t* gp = rg + ((size_t)b * SEQ + c * 64 + tk) * 1024 + ch0 + nt * 16 + fr;
                    const float gv = bf2f(*gp);
                    wt_store2(gp, (bf16_t)(pk2(hv * gelu_tanh(gv), 0.f) & 0xffffu));
                }
            }
            hin[nt] = Ta * hin[nt] + Th; atot[nt] *= Ta;
        }
    }
    if (pass == 0 && fq == 0) {
#pragma unroll
        for (int nt = 0; nt < 4; ++nt) {
            const size_t o = ((size_t)b * 128 + c) * 1024 + ch0 + nt * 16 + fr;
            wt_store4f((float*)(p.ws + OFF_LA) + o, atot[nt]); wt_store4f((float*)(p.ws + OFF_LH) + o, hin[nt]);
        }
    }
}
DEV void lru_carry(CParams& p) {
    float* LA = (float*)(p.ws + OFF_LA); float* LH = (float*)(p.ws + OFF_LH);
    for (int i = blockIdx.x * 256 + tidx(); i < NB * 1024; i += gridDim.x * 256) {
        const int b = i >> 10, ch = i & 1023;
        float carry = 0.f;
        for (int c = 0; c < 128; ++c) {
            const size_t o = ((size_t)b * 128 + c) * 1024 + ch;
            const float a = LA[o], h = LH[o];
            wt_store4f(&LH[o], carry); carry = a * carry + h;
        }
    }
}

DEV void phase_mix(CParams& p, int l, int which, lds_char* smem) {
    const int G = gridDim.x, bid = blockIdx.x;
    if (which == 0) {
        for (int u = bid; u < 4096; u += G) diff_unit(p, l, u, smem);
        for (int u = bid; u < 4096; u += G) dil_unit(p, 0, u, smem);
        for (int u = bid; u < 4096; u += G) lru_unit(p, l, u, 0, smem);
    } else if (which == 1) {
        lru_carry(p);
        for (int u = bid; u < 4096; u += G) dil_unit(p, 1, u, smem);
    } else {
        for (int u = bid; u < 4096; u += G) dil_unit(p, 2, u, smem);
#ifndef DBG_NO_LRU1
        for (int u = bid; u < 4096; u += G) lru_unit(p, l, u, 1, smem);
#endif
    }
}

DEV void phase_merge(CParams& p, int l, lds_char* smem) {
    const int G = gridDim.x, bid = blockIdx.x;
    const bf16_t* xb = (const bf16_t*)(p.ws + OFF_XB);
    const bf16_t* WT = (const bf16_t*)(p.ws + OFF_WT) + (size_t)l * WL_ELEMS;
    for (int u = bid; u < 512 * 16; u += G) {
        const int m0 = (u >> 4) * 128, n0 = (u & 15) * 64;
        f32x4 accM[2][4]; zero_acc<2>(accM);
#pragma unroll 1
        for (int i = 0; i < 3; ++i) {
            f32x4 acc[2][4]; zero_acc<2>(acc);
            gemm_acc<2>(acc, xb, 1024, m0, WT + W_IN + (size_t)(5120 + i * 1024) * 1024, 1024, n0, 1024, smem);
            unsigned gp[2][4][2];
#pragma unroll
            for (int m = 0; m < 2; ++m)
#pragma unroll
                for (int n = 0; n < 4; ++n) { gp[m][n][0] = pk2(sigmoidf_(acc[m][n][0]), sigmoidf_(acc[m][n][1])); gp[m][n][1] = pk2(sigmoidf_(acc[m][n][2]), sigmoidf_(acc[m][n][3])); }
            zero_acc<2>(acc);
            const bf16_t* A = (i == 0) ? (const bf16_t*)(p.ws + OFF_AQ) : (i == 1) ? (const bf16_t*)(p.ws + OFF_RG) : (const bf16_t*)(p.ws + OFF_OC);
            const int Ki = (i == 1) ? 1024 : 512;
            const bf16_t* Bt = WT + ((i == 0) ? W_BRA : (i == 1) ? W_BRB : W_BRC);
            gemm_acc<2>(acc, A, Ki, m0, Bt, Ki, n0, Ki, smem);
#pragma unroll
            for (int m = 0; m < 2; ++m)
#pragma unroll
                for (int n = 0; n < 4; ++n) {
                    accM[m][n][0] += bflo(gp[m][n][0]) * acc[m][n][0]; accM[m][n][1] += bfhi(gp[m][n][0]) * acc[m][n][1];
                    accM[m][n][2] += bflo(gp[m][n][1]) * acc[m][n][2]; accM[m][n][3] += bfhi(gp[m][n][1]) * acc[m][n][3];
                }
        }
        epi_bf16<2>(accM, (bf16_t*)(p.ws + OFF_MERGED), 1024, m0, n0);
    }
}
DEV void phase_gemm_res(CParams& p, const bf16_t* A, int K, const bf16_t* Bt, const float* res, lds_char* smem) {
    const int G = gridDim.x, bid = blockIdx.x;
    for (int u = bid; u < 512 * 8; u += G) {
        const int m0 = (u >> 3) * 128, n0 = (u & 7) * 128;
        f32x4 acc[4][4]; zero_acc<4>(acc);
        gemm_acc<4>(acc, A, K, m0, Bt, K, n0, K, smem);
        epi_res(acc, res, p.out, m0, n0);
    }
}
#ifndef XQ_COH
#define XQ_COH false
#endif
DEV void phase_xq(CParams& p, int l, lds_char* smem) {
    const int G = gridDim.x, bid = blockIdx.x;
    const bf16_t* WT = (const bf16_t*)(p.ws + OFF_WT) + (size_t)l * WL_ELEMS;
#ifdef DBG_XQ_DELAY
    { const unsigned long long t0 = __builtin_amdgcn_s_memrealtime(); while (__builtin_amdgcn_s_memrealtime() - t0 < 50000ull) __builtin_amdgcn_s_sleep(8); }
#endif
#ifdef DBG_XQ_A_MERGED
    const bf16_t* xb = (const bf16_t*)(p.ws + OFF_MERGED);
#elif defined(DBG_XB2)
    const bf16_t* xb = (const bf16_t*)(p.ws + 984 * MiB);
#elif defined(DBG_XQ_F32)
    const bf16_t* xb = (const bf16_t*)p.out;
#else
    const bf16_t* xb = (const bf16_t*)(p.ws + OFF_XB);
#endif
#ifndef DBG_XQW
#define DBG_XQW W_XQ
#endif
    const bf16_t* Wq = WT + DBG_XQW;
#ifdef DBG_XB2
    bf16_t* qx = (bf16_t*)(p.ws + OFF_QX);
    for (int u = bid; u < 128 * 8; u += G) {
#elif defined(DBG_QX_ALT)
    bf16_t* qx = (bf16_t*)(p.ws + 984 * MiB);
    for (int u = bid; u < 128 * 8; u += G) {
#else
    bf16_t* qx = (bf16_t*)(p.ws + OFF_QX);
    for (int u = bid; u < 512 * 8; u += G) {
#endif
#ifdef DBG_XQ_MAP2
        const int m0 = (u & 511) * 128, n0 = (u >> 9) * 128;
#else
        const int m0 = (u >> 3) * 128, n0 = (u & 7) * 128;
#endif
        f32x4 acc[4][4]; zero_acc<4>(acc);
        gemm_acc<4, XQ_COH>(acc, xb, 1024, m0, Wq, 1024, n0, 1024, smem);
        epi_bf16<4>(acc, qx, 1024, m0, n0);
    }
}
DEV void phase_memkv(CParams& p, int l, lds_char* smem) {
    const int G = gridDim.x, bid = blockIdx.x;
    const bf16_t* WT = (const bf16_t*)(p.ws + OFF_WT) + (size_t)l * WL_ELEMS;
    for (int t = bid; t < 256; t += G) {
        f32x4 acc[4][4]; zero_acc<4>(acc);
        const int m0 = (t >> 4) * 128, n0 = (t & 15) * 128;
        gemm_acc<4>(acc, (const bf16_t*)(p.ws + OFF_MEMB), 1024, m0, WT + W_XKV, 1024, n0, 1024, smem);
        epi_bf16<4>(acc, (bf16_t*)(p.ws + OFF_MEMKV) + (size_t)l * 2048 * 2048, 2048, m0, n0);
    }
}
DEV void phase_up(CParams& p, int l, lds_char* smem) {
    const int G = gridDim.x, bid = blockIdx.x;
    const bf16_t* WT = (const bf16_t*)(p.ws + OFF_WT) + (size_t)l * WL_ELEMS;
    const bf16_t* xb = (const bf16_t*)(p.ws + OFF_XB);
    for (int u = bid; u < 512 * 22; u += G) {
        const int m0 = (u / 22) * 128, n0 = (u % 22) * 128;
        f32x4 acc[4][4]; zero_acc<4>(acc);
        gemm_acc<4>(acc, xb, 1024, m0, WT + W_UP, 1024, n0, 1024, smem);
        unsigned gp[4][4][2];
#pragma unroll
        for (int m = 0; m < 4; ++m)
#pragma unroll
            for (int n = 0; n < 4; ++n) {
                f32x4 g = acc[m][n];
#pragma unroll
                for (int j = 0; j < 4; ++j) g[j] = g[j] * sigmoidf_(g[j]);
                gp[m][n][0] = pk2(g[0], g[1]); gp[m][n][1] = pk2(g[2], g[3]);
            }
        zero_acc<4>(acc);
        gemm_acc<4>(acc, xb, 1024, m0, WT + W_UP + (size_t)2816 * 1024, 1024, n0, 1024, smem);
#pragma unroll
        for (int m = 0; m < 4; ++m)
#pragma unroll
            for (int n = 0; n < 4; ++n) {
                acc[m][n][0] *= bflo(gp[m][n][0]); acc[m][n][1] *= bfhi(gp[m][n][0]); acc[m][n][2] *= bflo(gp[m][n][1]); acc[m][n][3] *= bfhi(gp[m][n][1]);
            }
        epi_bf16<4>(acc, (bf16_t*)(p.ws + OFF_HMID), 2816, m0, n0);
    }
}

DEV void phase_ln(CParams& p, const float* g, const float* bta) {
    const int lane = tidx() & 63, w = tidx() >> 6;
    f32x4 gv[4], bv[4];
#pragma unroll
    for (int i = 0; i < 4; ++i) { gv[i] = *(const f32x4*)(g + i * 256 + lane * 4); bv[i] = *(const f32x4*)(bta + i * 256 + lane * 4); }
    for (int row = blockIdx.x * 4 + w; row < NTOK; row += gridDim.x * 4) {
        float* xr = p.out + (size_t)row * DM;
        f32x4 v[4]; float s = 0.f;
#pragma unroll
        for (int i = 0; i < 4; ++i) { v[i] = *(const f32x4*)(xr + i * 256 + lane * 4); s += v[i][0] + v[i][1] + v[i][2] + v[i][3]; }
#pragma unroll
        for (int o = 32; o >= 1; o >>= 1) s += __shfl_xor(s, o);
        const float mean = s * (1.0f / 1024.0f);
        float q = 0.f;
#pragma unroll
        for (int i = 0; i < 4; ++i) { v[i] = v[i] - mean; q += v[i][0] * v[i][0] + v[i][1] * v[i][1] + v[i][2] * v[i][2] + v[i][3] * v[i][3]; }
#pragma unroll
        for (int o = 32; o >= 1; o >>= 1) q += __shfl_xor(q, o);
        const float rstd = rsqrtf(q * (1.0f / 1024.0f) + 1e-5f);
        bf16_t* xbr = (bf16_t*)(p.ws + OFF_XB) + (size_t)row * DM;
#pragma unroll
        for (int i = 0; i < 4; ++i) {
            f32x4 y = v[i] * rstd * gv[i] + bv[i];
#ifdef DBG_SANITIZE
            for (int e = 0; e < 4; ++e) if (!(fabsf(y[e]) < 1e30f)) y[e] = 0.f;
#endif
            wt_store16(xr + i * 256 + lane * 4, __builtin_bit_cast(u32x4, y));
            u32x2 r; r.x = pk2(y[0], y[1]); r.y = pk2(y[2], y[3]);
            wt_store8(xbr + i * 256 + lane * 4, r);
#ifdef DBG_XB2
            if (row < 16384) wt_store8((bf16_t*)(p.ws + 984 * MiB) + (size_t)row * DM + i * 256 + lane * 4, r);
#endif
        }
    }
}

#ifdef DBG_PH_HI
#define EN(k) ((k) < DBG_PH_HI - 1)
#else
#define EN(k) 1
#endif
constexpr int PH_PER_LAYER = 14, N_PHASES = 1 + 2 * PH_PER_LAYER;
DEV void run_phase(CParams& p, int ph, lds_char* smem) {
    if (ph == 0) { phase_prep(p, smem); return; }
    const int l = (ph - 1) / PH_PER_LAYER, k = (ph - 1) % PH_PER_LAYER;
    const bf16_t* WT = (const bf16_t*)(p.ws + OFF_WT) + (size_t)l * WL_ELEMS;
    switch (k) {
        case 0:
#if EN(0)
            phase_u(p, l, smem);
#ifdef DBG_XQ_IN_P1
            phase_xq(p, l, smem);
#endif
#endif
            break;
        case 1:
#if EN(1)
            phase_mix(p, l, 0, smem);
#endif
            break;
        case 2:
#if EN(2)
            phase_mix(p, l, 1, smem);
#endif
            break;
        case 3:
#if EN(3)
            phase_mix(p, l, 2, smem);
#endif
            break;
        case 4:
#if EN(4)
            phase_merge(p, l, smem);
#endif
            break;
        case 5:
#if EN(5)
            phase_gemm_res(p, (const bf16_t*)(p.ws + OFF_MERGED), 1024, WT + W_OUT, (l == 0) ? p.in[I_X] : p.out, smem);
#endif
            break;
        case 6:
#if EN(6) && !defined(DBG_SKIP_LN1)
            phase_ln(p, p.in[I_LN1G] + l * 1024, p.in[I_LN1B] + l * 1024);
#endif
            break;
        case 7:
#if EN(7)
            phase_xq(p, l, smem);
            phase_memkv(p, l, smem);
#endif
            break;
        case 8:
#if EN(8)
            for (int u = blockIdx.x; u < 4096; u += gridDim.x) xattn_unit(p, l, u, smem);
#endif
            break;
        case 9:
#if EN(9)
            phase_gemm_res(p, (const bf16_t*)(p.ws + OFF_QX), 1024, WT + W_XO, p.out, smem);
#endif
            break;
        case 10:
#if EN(10)
            phase_ln(p, p.in[I_LN2G] + l * 1024, p.in[I_LN2B] + l * 1024);
#endif
            break;
        case 11:
#if EN(11)
            phase_up(p, l, smem);
#endif
            break;
        case 12:
#if EN(12)
            phase_gemm_res(p, (const bf16_t*)(p.ws + OFF_HMID), 2816, WT + W_DOWN, p.out, smem);
#endif
            break;
        default:
#if EN(13)
            phase_ln(p, p.in[I_LN3G] + l * 1024, p.in[I_LN3B] + l * 1024);
#endif
            break;
    }
}

template <int K>
__global__ void __launch_bounds__(256, 2) phase_kernel(Params p, int l) {
    extern __shared__ __attribute__((aligned(16))) char smem_raw[];
    lds_char* smem = (lds_char*)smem_raw;
    CParams* kp = (CParams*)__builtin_amdgcn_kernarg_segment_ptr();
    CParams& q = *kp;
    const bf16_t* WT = (const bf16_t*)(q.ws + OFF_WT) + (size_t)l * WL_ELEMS;
    if (K == 99) phase_prep(q, smem);
    else if (K == 0) phase_u(q, l, smem);
    else if (K == 1) phase_mix(q, l, 0, smem);
    else if (K == 2) phase_mix(q, l, 1, smem);
    else if (K == 3) phase_mix(q, l, 2, smem);
    else if (K == 4) phase_merge(q, l, smem);
    else if (K == 5) phase_gemm_res(q, (const bf16_t*)(q.ws + OFF_MERGED), 1024, WT + W_OUT, (l == 0) ? q.in[I_X] : q.out, smem);
    else if (K == 6) phase_ln(q, q.in[I_LN1G] + l * 1024, q.in[I_LN1B] + l * 1024);
    else if (K == 7) phase_xq(q, l, smem);
    else if (K == 14) phase_memkv(q, l, smem);
    else if (K == 8) { for (int u = blockIdx.x; u < 4096; u += gridDim.x) xattn_unit(q, l, u, smem); }
    else if (K == 9) phase_gemm_res(q, (const bf16_t*)(q.ws + OFF_QX), 1024, WT + W_XO, q.out, smem);
    else if (K == 10) phase_ln(q, q.in[I_LN2G] + l * 1024, q.in[I_LN2B] + l * 1024);
    else if (K == 11) phase_up(q, l, smem);
    else if (K == 12) phase_gemm_res(q, (const bf16_t*)(q.ws + OFF_HMID), 2816, WT + W_DOWN, q.out, smem);
    else phase_ln(q, q.in[I_LN3G] + l * 1024, q.in[I_LN3B] + l * 1024);
}
#ifdef DBG_SPLIT_STOP
__global__ void __launch_bounds__(256, 2) dump_kernel(Params p) {
    const size_t NW = DBG_NW;
    for (size_t i = (size_t)blockIdx.x * 256 + threadIdx.x; i < 3 * NW; i += (size_t)gridDim.x * 256) {
        const size_t r = i / NW, j = i % NW;
        const size_t off = (r == 0) ? (size_t)DBG_DUMP_OFF : (r == 1) ? (size_t)DBG_DUMP_OFF2 : (size_t)DBG_DUMP_OFF3;
#ifdef DBG_DUMP_F32
        float a0 = p.out[2 * i], a1 = p.out[2 * i + 1];
#else
        const unsigned v = ((const unsigned*)(p.ws + off))[j]; float a0 = bflo(v), a1 = bfhi(v);
#endif
        const float mk = (r == 0) ? 1.0e3f : (r == 1) ? 1.0e5f : 1.0e7f;
        if (!(fabsf(a0) < 1e30f)) a0 = mk; if (!(fabsf(a1) < 1e30f)) a1 = mk;
        p.out[2 * i] = a0; p.out[2 * i + 1] = a1;
    }
}
#endif
template <int K>
static void launch_phase(const Params& p, int l, int grid, hipStream_t stream) {
    hipFuncSetAttribute((const void*)phase_kernel<K>, hipFuncAttributeMaxDynamicSharedMemorySize, SMEM_BYTES);
    hipLaunchKernelGGL(phase_kernel<K>, dim3(grid), dim3(256), SMEM_BYTES, stream, p, l);
}
__global__ void __launch_bounds__(256, 2) mega(Params p) {
    extern __shared__ __attribute__((aligned(16))) char smem_raw[];
    lds_char* smem = (lds_char*)smem_raw;
    cg::grid_group grid = cg::this_grid();
    const int ph_lo = p.ph_lo, ph_hi = p.ph_hi;
    unsigned nbar = 0;
    if (ph_lo < 0) grid.sync();
    for (int ph = ph_lo; ph < ph_hi; ++ph) {
        CParams* kp = (CParams*)__builtin_amdgcn_kernarg_segment_ptr();
        asm volatile("" : "+s"(kp));
#ifdef DBG_SELFCHECK
        if (ph == DBG_PH_HI + 1) {
            if (blockIdx.x == 0 && tidx() == 0) {
                const unsigned c = __hip_atomic_load((unsigned*)(kp->ws + 64), __ATOMIC_RELAXED, __HIP_MEMORY_SCOPE_AGENT);
                const float b = (float)((c + 16384u) / 32768u);
                kp->out[0] = 1.0e6f * b + 7.0e5f * (float)(c < 1000000u ? c : 999999u) / 1.0e6f * 0.f;
            }
        } else
#endif
#if defined(DBG_DUMP_OFF) && defined(DBG_PH_HI)
        if (ph == DBG_PH_HI) {
#ifndef DBG_NW
#define DBG_NW 10485760
#endif
#ifndef DBG_COLEXPR
#define DBG_COLEXPR (((int)(i & 15) * 61 + (int)(row & 63)) % DBG_NCOL)
#endif
#ifdef DBG_SELFCHECK
            {
                const bf16_t* Ap = (const bf16_t*)(kp->ws + DBG_A_OFF);
                const bf16_t* Wp = (const bf16_t*)(kp->ws + OFF_WT) + DBG_W_OFF;
                const bf16_t* Cp = (const bf16_t*)(kp->ws + DBG_C_OFF);
                for (size_t i = (size_t)blockIdx.x * 256 + tidx(); i < (size_t)DBG_ROWS * 16; i += (size_t)gridDim.x * 256) {
                    const size_t row = i >> 4; const int col = DBG_COLEXPR;
                    float acc = 0.f;
                    for (int k = 0; k < 1024; ++k) {
#ifdef DBG_A_FROM_X
                        const float av = bflo(pk2(kp->in[I_X][row * 1024 + k], 0.f));
#elif defined(DBG_A_FROM_OUT)
                        const float av = bflo(pk2(kp->out[row * 1024 + k], 0.f));
#else
                        const float av = bf2f(Ap[row * 1024 + k]);
#endif
                        acc += av * bf2f(Wp[(size_t)col * 1024 + k]); }
                    const float st = bf2f(Cp[row * DBG_LDC + col]);
                    if (!(fabsf(acc - st) <= 0.02f + 0.02f * fabsf(acc))) atomicAdd((unsigned*)(kp->ws + 64), 1u);
                }
            }
#else
            const size_t NW = DBG_NW;
            for (size_t i = (size_t)blockIdx.x * 256 + tidx(); i < 3 * NW; i += (size_t)gridDim.x * 256) {
                const size_t r = i / NW, j = i % NW;
                const size_t off = (r == 0) ? (size_t)DBG_DUMP_OFF : (r == 1) ? (size_t)DBG_DUMP_OFF2 : (size_t)DBG_DUMP_OFF3;
                const unsigned v = ((const unsigned*)(kp->ws + off))[j]; { float a0 = bflo(v), a1 = bfhi(v); if (!(fabsf(a0) < 1e30f)) a0 = 12345.0f; if (!(fabsf(a1) < 1e30f)) a1 = 12345.0f; kp->out[2 * i] = a0; kp->out[2 * i + 1] = a1; }
            }
#endif
        } else
#endif
        run_phase(*kp, ph, smem);
        if (ph + 1 < ph_hi) {
#ifdef DBG_SKEW
            if ((blockIdx.x & 15) == 3) { const unsigned long long t0 = __builtin_amdgcn_s_memrealtime(); while (__builtin_amdgcn_s_memrealtime() - t0 < 30000ull) __builtin_amdgcn_s_sleep(8); }
#endif
            __builtin_amdgcn_fence(__ATOMIC_RELEASE, "agent");
            __syncthreads();
            ++nbar;
            if (tidx() == 0) {
                unsigned* ctr = (unsigned*)kp->ws;
                __hip_atomic_fetch_add(ctr, 1u, __ATOMIC_RELAXED, __HIP_MEMORY_SCOPE_AGENT);
                const unsigned target = nbar * gridDim.x;
                while (__hip_atomic_load(ctr, __ATOMIC_RELAXED, __HIP_MEMORY_SCOPE_AGENT) < target) __builtin_amdgcn_s_sleep(2);
            }
            __syncthreads();
            __builtin_amdgcn_fence(__ATOMIC_ACQUIRE, "agent");
        }
    }
}

extern "C" void kernel_launch(void* const* d_in, const int* in_sizes, int n_in, void* d_out, int out_size, void* d_ws, size_t ws_size, hipStream_t stream) {
    static int grid_blocks = 0;
    hipFuncSetAttribute((const void*)mega, hipFuncAttributeMaxDynamicSharedMemorySize, SMEM_BYTES);
    if (!grid_blocks) {
        int dev = 0, cus = 0, per_cu = 0;
        hipGetDevice(&dev);
        hipDeviceGetAttribute(&cus, hipDeviceAttributeMultiprocessorCount, dev);
        hipOccupancyMaxActiveBlocksPerMultiprocessor(&per_cu, mega, 256, SMEM_BYTES);
        if (per_cu < 1) per_cu = 1;
        if (per_cu > 2) per_cu = 2;
        grid_blocks = cus * per_cu;
    }
    hipMemsetAsync(d_ws, 0, 256, stream);
#ifdef DBG_SELFCHECK
    hipMemsetAsync(d_out, 0, 256, stream);
#endif
    Params p{};
    for (int i = 0; i < 25; ++i) p.in[i] = (const float*)d_in[i];
    p.out = (float*)d_out; p.ws = (char*)d_ws; p.ph_lo = 0; p.ph_hi = N_PHASES;
#ifdef DBG_PH_HI
#ifdef DBG_SELFCHECK
    p.ph_hi = DBG_PH_HI + 2;
#else
    p.ph_hi = DBG_PH_HI + 1;
#endif
#endif
    if (ws_size < 980 * MiB) return;
#if defined(MK_SPLIT)
    hipError_t e = hipSuccess;
    launch_phase<99>(p, 0, grid_blocks, stream);
    int nrun = 0;
#ifdef DBG_SPLIT_STOP
    const int nmax = DBG_SPLIT_STOP;
#else
    const int nmax = 30;
#endif
#define LP(K) if (nrun++ < nmax) launch_phase<K>(p, l, grid_blocks, stream)
    for (int l = 0; l < 2; ++l) {
        LP(0); LP(1); LP(2); LP(3); LP(4); LP(5); LP(6); LP(7); LP(14); LP(8); LP(9); LP(10); LP(11); LP(12); LP(13);
    }
#ifdef DBG_SPLIT_STOP
    hipLaunchKernelGGL(dump_kernel, dim3(grid_blocks), dim3(256), 0, stream, p);
#endif
#elif defined(MK_MULTI)
    hipError_t e = hipSuccess;

    const int nph = p.ph_hi;
    for (int ph = 0; ph < nph; ++ph) {
        p.ph_lo = ph; p.ph_hi = ph + 1;
        hipLaunchKernelGGL(mega, dim3(grid_blocks), dim3(256), SMEM_BYTES, stream, p);
    }
#else
    void* args[] = {&p};
    hipError_t e = hipLaunchCooperativeKernel((void*)mega, dim3(grid_blocks), dim3(256), args, SMEM_BYTES, stream);
#endif
    if (e != hipSuccess) fprintf(stderr, "cooperative launch failed: %s (grid %d)\n", hipGetErrorString(e), grid_blocks);
}
```

```cpp
#include <hip/hip_runtime.h>
#include <hip/hip_cooperative_groups.h>
#include <cstdio>
#include <cstdint>
namespace cg = cooperative_groups;

typedef unsigned short bf16_t;
typedef short bf16x8 __attribute__((ext_vector_type(8)));
typedef short s16x4 __attribute__((ext_vector_type(4)));
typedef float f32x4 __attribute__((ext_vector_type(4)));
typedef unsigned u32x4 __attribute__((ext_vector_type(4)));
typedef unsigned u32x2 __attribute__((ext_vector_type(2)));
#define LDS __attribute__((address_space(3)))
typedef LDS char lds_char;
#define DEV __device__ __forceinline__

constexpr int SEQ = 8192, NB = 8, DM = 1024, NTOK = NB * SEQ;
constexpr int SMEM_BYTES = 77824;
constexpr float ALPHA = 1.41421356237309515f;
constexpr float LOG2E = 1.44269504088896341f;
constexpr float LN2 = 0.69314718055994531f;

constexpr size_t MiB = 1048576;
constexpr size_t WL_ELEMS = 24510464;
constexpr size_t OFF_WT = 1 * MiB;
constexpr size_t OFF_MEMB = 100 * MiB;
constexpr size_t OFF_MEMKV = 964 * MiB;
constexpr size_t OFF_XB = 120 * MiB;
constexpr size_t OFF_AQ = 248 * MiB, OFF_AK = 312 * MiB, OFF_AV = 376 * MiB, OFF_RX = 440 * MiB, OFF_RG = 568 * MiB,
                 OFF_CQ = 696 * MiB, OFF_CK = 760 * MiB, OFF_CV = 824 * MiB, OFF_OC = 888 * MiB, OFF_LSE = 952 * MiB,
                 OFF_LA = 954 * MiB, OFF_LH = 958 * MiB;
constexpr size_t OFF_MERGED = OFF_RX, OFF_QX = OFF_AK, OFF_HMID = OFF_AQ;
constexpr size_t W_IN = 0, W_BRA = 8388608, W_BRB = 8912896, W_BRC = 9961472, W_OUT = 10485760, W_XQ = 11534336,
                 W_XKV = 12582912, W_XO = 14680064, W_UP = 15728640, W_DOWN = 21495808, W_GW = 24379392;

struct Params {
    const float* in[25];
    float* out;
    char* ws;
    int ph_lo, ph_hi;
};
typedef const __attribute__((address_space(4))) Params CParams;
enum { I_X = 0, I_MEM, I_WIN, I_LAMQK, I_SUBLN, I_CONVW, I_CONVB, I_GATEW, I_GATEB, I_LAMBDA, I_BRA, I_BRB, I_BRC, I_WOUT,
       I_LN1G, I_LN1B, I_XQ, I_XKV, I_XO, I_LN2G, I_LN2B, I_WUP, I_WDOWN, I_LN3G, I_LN3B };

DEV unsigned pk2(float lo, float hi) { unsigned r; asm("v_cvt_pk_bf16_f32 %0, %1, %2" : "=v"(r) : "v"(lo), "v"(hi)); return r; }
DEV float bf2f(bf16_t v) { return __uint_as_float((unsigned)v << 16); }
DEV float bflo(unsigned v) { return __uint_as_float(v << 16); }
DEV float bfhi(unsigned v) { return __uint_as_float(v & 0xffff0000u); }
DEV float fexp2(float x) { return __builtin_amdgcn_exp2f(x); }
DEV float fexp(float x) { return __builtin_amdgcn_exp2f(x * LOG2E); }
DEV float sigmoidf_(float x) { return 1.0f / (1.0f + fexp(-x)); }
DEV int tidx() { int t = __builtin_amdgcn_workitem_id_x(); asm volatile("" : "+v"(t)); return t; }
#ifndef WT_SCOPE
#define WT_SCOPE __HIP_MEMORY_SCOPE_AGENT
#endif
DEV void wt_store8(void* ptr, u32x2 v) { *(u32x2*)ptr = v; }
DEV void wt_store4f(float* ptr, float v) { *ptr = v; }
DEV void wt_store2(bf16_t* ptr, bf16_t v) { *ptr = v; }
DEV void wt_store16(void* ptr, u32x4 v) { *(u32x4*)ptr = v; }
#define MFMA(a, b, c) __builtin_amdgcn_mfma_f32_16x16x32_bf16((a), (b), (c), 0, 0, 0)

DEV u32x4 coh_load16(const bf16_t* ptr) {
    const unsigned long long* q = (const unsigned long long*)ptr;
    const unsigned long long a = __hip_atomic_load(q, __ATOMIC_RELAXED, __HIP_MEMORY_SCOPE_SYSTEM);
    const unsigned long long b = __hip_atomic_load(q + 1, __ATOMIC_RELAXED, __HIP_MEMORY_SCOPE_SYSTEM);
    u32x4 r; r.x = (unsigned)a; r.y = (unsigned)(a >> 32); r.z = (unsigned)b; r.w = (unsigned)(b >> 32); return r;
}
template <int MI, bool COH>
DEV void gemm_gload(const bf16_t* A, int lda, int m0, const bf16_t* Bt, int ldb, int n0, int k0, u32x4 (&ra)[4], u32x4 (&rb)[MI]) {
    const int T = tidx();
#pragma unroll
    for (int i = 0; i < 4; ++i) {
        const int q = i * 256 + T, r = q >> 3, lc = (q & 7) ^ (r & 7);
        if (COH) {
#ifdef DBG_XQ_F32
            { const float* Af = (const float*)A + (size_t)(m0 + r) * lda + k0 + lc * 8; const f32x4 v0 = *(const f32x4*)Af, v1 = *(const f32x4*)(Af + 4); u32x4 t; t.x = pk2(v0[0], v0[1]); t.y = pk2(v0[2], v0[3]); t.z = pk2(v1[0], v1[1]); t.w = pk2(v1[2], v1[3]); ra[i] = t; }
            if (i < MI) rb[i] = *(const u32x4*)(Bt + (size_t)(n0 + r) * ldb + k0 + lc * 8);
            continue;
#endif
            ra[i] = coh_load16(A + (size_t)(m0 + r) * lda + k0 + lc * 8);
            if (i < MI) rb[i] = coh_load16(Bt + (size_t)(n0 + r) * ldb + k0 + lc * 8);
        } else {
            ra[i] = *(const u32x4*)(A + (size_t)(m0 + r) * lda + k0 + lc * 8);
            if (i < MI) rb[i] = *(const u32x4*)(Bt + (size_t)(n0 + r) * ldb + k0 + lc * 8);
        }
    }
}
template <int MI>
DEV void gemm_sstore(lds_char* st, const u32x4 (&ra)[4], const u32x4 (&rb)[MI]) {
    const int T = tidx();
#pragma unroll
    for (int i = 0; i < 4; ++i) {
        const int q = i * 256 + T;
        *(LDS u32x4*)(st + q * 16) = ra[i];
        if (i < MI) *(LDS u32x4*)(st + 16384 + q * 16) = rb[i];
    }
}
template <int MI, bool COH = false>
DEV void gemm_acc(f32x4 (&acc)[MI][4], const bf16_t* A, int lda, int m0, const bf16_t* Bt, int ldb, int n0, int K, lds_char* smem) {
    constexpr int WN = MI / 2;
    const int T = tidx(), lane = T & 63, w = T >> 6, wr = w / WN, wc = w % WN, fr = lane & 15, fq = lane >> 4;
    const int nt = K >> 6;
    u32x4 ra[4], rb[MI];
    gemm_gload<MI, COH>(A, lda, m0, Bt, ldb, n0, 0, ra, rb);
    __syncthreads();
    for (int t = 0; t < nt; ++t) {
        lds_char* a = smem + (t & 1) * 32768;
        lds_char* b = a + 16384;
        gemm_sstore<MI>(a, ra, rb);
        __syncthreads();
        if (t + 1 < nt) gemm_gload<MI, COH>(A, lda, m0, Bt, ldb, n0, (t + 1) * 64, ra, rb);
        __builtin_amdgcn_sched_barrier(0);
#pragma unroll
        for (int ks = 0; ks < 2; ++ks) {
            bf16x8 af[MI], bfr[4];
#pragma unroll
            for (int m = 0; m < MI; ++m) { const int r = wr * (MI * 16) + m * 16 + fr; af[m] = *(const LDS bf16x8*)(a + r * 128 + (((ks * 4 + fq) ^ (r & 7)) << 4)); }
#pragma unroll
            for (int n = 0; n < 4; ++n) { const int r = wc * 64 + n * 16 + fr; bfr[n] = *(const LDS bf16x8*)(b + r * 128 + (((ks * 4 + fq) ^ (r & 7)) << 4)); }
#pragma unroll
            for (int m = 0; m < MI; ++m)
#pragma unroll
                for (int n = 0; n < 4; ++n) acc[m][n] = MFMA(bfr[n], af[m], acc[m][n]);
        }
    }
}
template <int MI>
DEV void zero_acc(f32x4 (&acc)[MI][4]) {
#pragma unroll
    for (int m = 0; m < MI; ++m)
#pragma unroll
        for (int n = 0; n < 4; ++n) acc[m][n] = (f32x4){0.f, 0.f, 0.f, 0.f};
}
#define GEMM_IDS_(MI) const int T = tidx(), lane = T & 63, w = T >> 6, wr = w / ((MI) / 2), wc = w % ((MI) / 2), fr = lane & 15, fq = lane >> 4; constexpr int MI_ = (MI); (void)T; (void)lane; (void)w
#define GEMM_IDS GEMM_IDS_(4)
#define CROW(m) (m0 + wr * (MI_ * 16) + (m) * 16 + fr)
#define CCOL(n) (n0 + wc * 64 + (n) * 16 + fq * 4)

template <int MI>
DEV void epi_bf16(const f32x4 (&acc)[MI][4], bf16_t* dst, int ld, int m0, int n0) {
    GEMM_IDS_(MI);
    float one = 1.0f; asm volatile("" : "+v"(one));
#pragma unroll
    for (int m = 0; m < MI; ++m)
#pragma unroll
        for (int n = 0; n < 4; ++n) {
            const f32x4 a = acc[m][n] * one;
            u32x2 v; v.x = pk2(a[0], a[1]); v.y = pk2(a[2], a[3]);
            wt_store8(dst + (size_t)CROW(m) * ld + CCOL(n), v);
        }
}
DEV void epi_res(const f32x4 (&acc)[4][4], const float* res, float* out, int m0, int n0) {
    GEMM_IDS;
#pragma unroll
    for (int m = 0; m < 4; ++m)
#pragma unroll
        for (int n = 0; n < 4; ++n) {
            const size_t o = (size_t)CROW(m) * DM + CCOL(n);
            const f32x4 r = *(const f32x4*)(res + o);
            { f32x4 a = acc[m][n];
#ifdef DBG_SANITIZE
              for (int e = 0; e < 4; ++e) if (!(fabsf(a[e]) < 1e30f)) a[e] = 0.f;
#endif
              const f32x4 y = r * ALPHA + a; wt_store16(out + o, __builtin_bit_cast(u32x4, y)); }
        }
}

DEV void transpose_tile(const float* __restrict__ src, int N, bf16_t* __restrict__ dst, int K, int k0, int n0, lds_char* smem) {
    LDS float* t = (LDS float*)smem;
    const int T = tidx();
    __syncthreads();
#pragma unroll
    for (int i = 0; i < 4; ++i) {
        const int q = i * 256 + T, r = q >> 4, c = (q & 15) * 4;
        const f32x4 v = *(const f32x4*)(src + (size_t)(k0 + r) * N + n0 + c);
        t[r * 65 + c] = v[0]; t[r * 65 + c + 1] = v[1]; t[r * 65 + c + 2] = v[2]; t[r * 65 + c + 3] = v[3];
    }
    __syncthreads();
#pragma unroll
    for (int i = 0; i < 2; ++i) {
        const int q = i * 256 + T, rr = q >> 3, cc = (q & 7) * 8;
        u32x4 v;
        v.x = pk2(t[(cc + 0) * 65 + rr], t[(cc + 1) * 65 + rr]); v.y = pk2(t[(cc + 2) * 65 + rr], t[(cc + 3) * 65 + rr]);
        v.z = pk2(t[(cc + 4) * 65 + rr], t[(cc + 5) * 65 + rr]); v.w = pk2(t[(cc + 6) * 65 + rr], t[(cc + 7) * 65 + rr]);
        wt_store16(dst + (size_t)(n0 + rr) * K + k0 + cc, v);
    }
}
DEV void phase_prep(CParams& p, lds_char* smem) {
    const int G = gridDim.x, bid = blockIdx.x, T = tidx();
    bf16_t* WT = (bf16_t*)(p.ws + OFF_WT);
    for (int u = bid; u < 2 * 5984; u += G) {
        const int l = u / 5984; int t = u % 5984;
        const float* src; size_t doff; int K, N;
        if (t < 2048) { src = p.in[I_WIN] + (size_t)l * 1024 * 8192; doff = W_IN; K = 1024; N = 8192; }
        else if ((t -= 2048) < 128) { src = p.in[I_BRA] + (size_t)l * 512 * 1024; doff = W_BRA; K = 512; N = 1024; }
        else if ((t -= 128) < 256) { src = p.in[I_BRB] + (size_t)l * 1024 * 1024; doff = W_BRB; K = 1024; N = 1024; }
        else if ((t -= 256) < 128) { src = p.in[I_BRC] + (size_t)l * 512 * 1024; doff = W_BRC; K = 512; N = 1024; }
        else if ((t -= 128) < 256) { src = p.in[I_WOUT] + (size_t)l * 1024 * 1024; doff = W_OUT; K = 1024; N = 1024; }
        else if ((t -= 256) < 256) { src = p.in[I_XQ] + (size_t)l * 1024 * 1024; doff = W_XQ; K = 1024; N = 1024; }
        else if ((t -= 256) < 512) { src = p.in[I_XKV] + (size_t)l * 1024 * 2048; doff = W_XKV; K = 1024; N = 2048; }
        else if ((t -= 512) < 256) { src = p.in[I_XO] + (size_t)l * 1024 * 1024; doff = W_XO; K = 1024; N = 1024; }
        else if ((t -= 256) < 1408) { src = p.in[I_WUP] + (size_t)l * 1024 * 5632; doff = W_UP; K = 1024; N = 5632; }
        else if ((t -= 1408) < 704) { src = p.in[I_WDOWN] + (size_t)l * 2816 * 1024; doff = W_DOWN; K = 2816; N = 1024; }
        else { t -= 704; src = p.in[I_GATEW] + (size_t)l * 131072 + (size_t)t * 4096; doff = W_GW + (size_t)t * 4096; K = 64; N = 64; t = 0; }
        const int tn = N >> 6;
        transpose_tile(src, N, WT + (size_t)l * WL_ELEMS + doff, K, (t / tn) * 64, (t % tn) * 64, smem);
    }
    {
        const f32x4* x4 = (const f32x4*)p.in[I_X]; u32x2* xb = (u32x2*)(p.ws + OFF_XB);
        for (size_t i = (size_t)bid * 256 + T; i < (size_t)NTOK * DM / 4; i += (size_t)G * 256) { const f32x4 v = x4[i]; u32x2 o; o.x = pk2(v[0], v[1]); o.y = pk2(v[2], v[3]); wt_store8(&xb[i], o); }
        const f32x4* m4 = (const f32x4*)p.in[I_MEM]; u32x2* mb = (u32x2*)(p.ws + OFF_MEMB);
        for (size_t i = (size_t)bid * 256 + T; i < (size_t)2048 * DM / 4; i += (size_t)G * 256) { const f32x4 v = m4[i]; u32x2 o; o.x = pk2(v[0], v[1]); o.y = pk2(v[2], v[3]); wt_store8(&mb[i], o); }
    }
}

DEV void rot_coef(int pos, float invf, float& c, float& s) {
    const float ang = (float)pos * invf;
    const float n = rintf(ang * 0.15915494309189535f);
    float r = fmaf(-n, 6.2831854820251465f, ang);
    r = fmaf(-n, -1.7484556025237907e-07f, r);
    c = __cosf(r); s = __sinf(r);
}
DEV void phase_u(CParams& p, int l, lds_char* smem) {
    const int G = gridDim.x, bid = blockIdx.x;
    const bf16_t* xb = (const bf16_t*)(p.ws + OFF_XB);
    const bf16_t* WT = (const bf16_t*)(p.ws + OFF_WT) + (size_t)l * WL_ELEMS;
    const int nkv = 0;
#ifdef DBG_U_XQ
    const int nu = 512 * 48 + nkv;
#else
    const int nu = 512 * 40 + nkv;
#endif
    for (int uu = bid; uu < nu; uu += G) {
        f32x4 acc[4][4]; zero_acc<4>(acc);
        if (uu < nkv) {
            const int v = uu, ll = v >> 8, t = v & 255, m0 = (t >> 4) * 128, n0 = (t & 15) * 128;
            gemm_acc<4, false>(acc, (const bf16_t*)(p.ws + OFF_MEMB), 1024, m0, (const bf16_t*)(p.ws + OFF_WT) + (size_t)ll * WL_ELEMS + W_XKV, 1024, n0, 1024, smem);
            epi_bf16<4>(acc, (bf16_t*)(p.ws + OFF_MEMKV) + (size_t)ll * 2048 * 2048, 2048, m0, n0);
            continue;
        }
        const int u = uu - nkv;
#ifdef DBG_U_XQ
        const int m0 = (u / 48) * 128, n0 = (u % 48) * 128;
        gemm_acc<4>(acc, xb, 1024, m0, (n0 < 5120) ? (WT + W_IN) : (WT + (W_XQ - (size_t)5120 * 1024)), 1024, n0, 1024, smem);
        if (n0 >= 5120) { if (m0 < 16384) epi_bf16<4>(acc, (bf16_t*)(p.ws + 984 * MiB), 1024, m0, n0 - 5120); continue; }
#else
        const int m0 = (u / 40) * 128, n0 = (u % 40) * 128;
        gemm_acc<4>(acc, xb, 1024, m0, WT + W_IN, 1024, n0, 1024, smem);
#endif
        bf16_t* dst; int ld, c0; bool rot = false;
        if (n0 < 512) { dst = (bf16_t*)(p.ws + OFF_AQ); ld = 512; c0 = n0; rot = true; }
        else if (n0 < 1024) { dst = (bf16_t*)(p.ws + OFF_AK); ld = 512; c0 = n0 - 512; rot = true; }
        else if (n0 < 1536) { dst = (bf16_t*)(p.ws + OFF_AV); ld = 512; c0 = n0 - 1024; }
        else if (n0 < 2560) { dst = (bf16_t*)(p.ws + OFF_RX); ld = 1024; c0 = n0 - 1536; }
        else if (n0 < 3584) { dst = (bf16_t*)(p.ws + OFF_RG); ld = 1024; c0 = n0 - 2560; }
        else if (n0 < 4096) { dst = (bf16_t*)(p.ws + OFF_CQ); ld = 512; c0 = n0 - 3584; rot = true; }
        else if (n0 < 4608) { dst = (bf16_t*)(p.ws + OFF_CK); ld = 512; c0 = n0 - 4096; rot = true; }
        else { dst = (bf16_t*)(p.ws + OFF_CV); ld = 512; c0 = n0 - 4608; }
        GEMM_IDS;
        if (rot) {
            const bool hi = (fq & 2) != 0, odd = (fq & 1) != 0;
            const float f0 = odd ? 0.001414213562373095f : 1.0f, f1 = odd ? 0.0002742481756762073f : 0.19392274474868576f,
                        f2 = odd ? 5.318295896944988e-05f : 0.03760603093086393f, f3 = odd ? 1.031338537721246e-05f : 0.007292664737217109f;
#pragma unroll
            for (int m = 0; m < 4; ++m) {
                const int pos = CROW(m) & (SEQ - 1);
                f32x4 v = acc[m][0], o;
#pragma unroll
                for (int j = 0; j < 4; ++j) {
                    const float pv = __shfl_xor(v[j], 32);
                    float c, s; rot_coef(pos, j == 0 ? f0 : j == 1 ? f1 : j == 2 ? f2 : f3, c, s);
                    o[j] = hi ? (v[j] * c + pv * s) : (v[j] * c - pv * s);
                }
                acc[m][0] = o;
            }
        }
        epi_bf16<4>(acc, dst, ld, m0, c0);
    }
}

template <int D, int DV, int KW, int MT, int MODE, bool PF>
DEV void flash_core(const bf16_t* __restrict__ Qp, int ldq, int qtok0, int qstride, int qrow0,
                    const bf16_t* __restrict__ Kp, int ldk, const bf16_t* __restrict__ Vp, int ldv, int ktok0, int kstride,
                    int kt_begin, int kt_end, int koff, float sc, int qpos0, lds_char* smem,
                    f32x4 (&o)[MT][DV / 16], float (&mrow)[MT], float (&lrow)[MT]) {
    const int T = tidx(), lane = T & 63, fr = lane & 15, fq = lane >> 4;
    constexpr int KSTR = KW * 2 + 16, VSTR = DV * 2 + 32;
    lds_char* Ks = smem;
    lds_char* Vs = smem + 64 * KSTR;
    constexpr int KCH = KW / 8, NKL = 64 * KCH / 256, VCH = DV / 8, NVL = 64 * VCH / 256;
    bf16x8 qf[MT][D / 32];
#pragma unroll
    for (int mt = 0; mt < MT; ++mt)
#pragma unroll
        for (int ks = 0; ks < D / 32; ++ks)
            qf[mt][ks] = *(const bf16x8*)(Qp + (size_t)(qtok0 + (qrow0 + mt * 16 + fr) * qstride) * ldq + ks * 32 + fq * 8);
#pragma unroll
    for (int mt = 0; mt < MT; ++mt) {
        mrow[mt] = -1e30f; lrow[mt] = 0.f;
#pragma unroll
        for (int dt = 0; dt < DV / 16; ++dt) o[mt][dt] = (f32x4){0.f, 0.f, 0.f, 0.f};
    }
    u32x4 kreg[NKL], vreg[NVL];
    if (PF && kt_begin < kt_end) {
#pragma unroll
        for (int i = 0; i < NKL; ++i) { const int q = i * 256 + T, row = q / KCH, ch = q % KCH; kreg[i] = *(const u32x4*)(Kp + (size_t)(ktok0 + (kt_begin * 64 + row) * kstride) * ldk + ch * 8); }
#pragma unroll
        for (int i = 0; i < NVL; ++i) { const int q = i * 256 + T, row = q / VCH, ch = q % VCH; vreg[i] = *(const u32x4*)(Vp + (size_t)(ktok0 + (kt_begin * 64 + row) * kstride) * ldv + ch * 8); }
    }
    const int vbase = (4 * fq + ((lane >> 2) & 3)) * VSTR + (lane & 3) * 8;
    for (int kt = kt_begin; kt < kt_end; ++kt) {
        if (!PF) {
#pragma unroll
            for (int i = 0; i < NKL; ++i) { const int q = i * 256 + T, row = q / KCH, ch = q % KCH; kreg[i] = *(const u32x4*)(Kp + (size_t)(ktok0 + (kt * 64 + row) * kstride) * ldk + ch * 8); }
#pragma unroll
            for (int i = 0; i < NVL; ++i) { const int q = i * 256 + T, row = q / VCH, ch = q % VCH; vreg[i] = *(const u32x4*)(Vp + (size_t)(ktok0 + (kt * 64 + row) * kstride) * ldv + ch * 8); }
        }
        __syncthreads();
#pragma unroll
        for (int i = 0; i < NKL; ++i) { const int q = i * 256 + T, row = q / KCH, ch = q % KCH; *(LDS u32x4*)(Ks + row * KSTR + ch * 16) = kreg[i]; }
#pragma unroll
        for (int i = 0; i < NVL; ++i) { const int q = i * 256 + T, row = q / VCH, ch = q % VCH; *(LDS u32x4*)(Vs + row * VSTR + ch * 16) = vreg[i]; }
        __syncthreads();
        if (PF && kt + 1 < kt_end) {
#pragma unroll
            for (int i = 0; i < NKL; ++i) { const int q = i * 256 + T, row = q / KCH, ch = q % KCH; kreg[i] = *(const u32x4*)(Kp + (size_t)(ktok0 + ((kt + 1) * 64 + row) * kstride) * ldk + ch * 8); }
#pragma unroll
            for (int i = 0; i < NVL; ++i) { const int q = i * 256 + T, row = q / VCH, ch = q % VCH; vreg[i] = *(const u32x4*)(Vp + (size_t)(ktok0 + ((kt + 1) * 64 + row) * kstride) * ldv + ch * 8); }
        }
        bool act = true;
        if (MODE == 1) act = (64 * kt + 63 >= qrow0) && (64 * kt <= qrow0 + MT * 16 - 1 + 128);
        if (act) {
            const bool domask = (MODE == 0) ? (kt == kt_end - 1) : (MODE == 1);
            bf16x8 pf[MT][2];
#pragma unroll
            for (int mt = 0; mt < MT; ++mt) {
                f32x4 s[4];
#pragma unroll
                for (int n = 0; n < 4; ++n) s[n] = (f32x4){0.f, 0.f, 0.f, 0.f};
#pragma unroll
                for (int ks = 0; ks < D / 32; ++ks) {
#pragma unroll
                    for (int n = 0; n < 4; ++n) {
                        const bf16x8 kf = *(const LDS bf16x8*)(Ks + (n * 16 + fr) * KSTR + (koff + ks * 32 + fq * 8) * 2);
                        s[n] = MFMA(kf, qf[mt][ks], s[n]);
                    }
                }
                const int qi = qrow0 + mt * 16 + fr;
                float mx = -INFINITY;
#pragma unroll
                for (int n = 0; n < 4; ++n)
#pragma unroll
                    for (int j = 0; j < 4; ++j) {
                        float v = s[n][j] * sc;
                        if (domask) {
                            const int kj = kt * 64 + n * 16 + fq * 4 + j;
                            bool ok;
                            if (MODE == 0) ok = kj <= qpos0 + qi; else ok = (kj >= qi) && (kj <= qi + 128);
                            if (!ok) v = -INFINITY;
                        }
                        s[n][j] = v; mx = fmaxf(mx, v);
                    }
                mx = fmaxf(mx, __shfl_xor(mx, 16)); mx = fmaxf(mx, __shfl_xor(mx, 32));
                const float mn = fmaxf(mrow[mt], mx);
                const float alpha = fexp2(mrow[mt] - mn);
                mrow[mt] = mn;
                float rs = 0.f;
#pragma unroll
                for (int n = 0; n < 4; ++n)
#pragma unroll
                    for (int j = 0; j < 4; ++j) { const float pe = fexp2(s[n][j] - mn); s[n][j] = pe; rs += pe; }
                lrow[mt] = lrow[mt] * alpha + rs;
#pragma unroll
                for (int dt = 0; dt < DV / 16; ++dt) o[mt][dt] *= alpha;
#pragma unroll
                for (int k2 = 0; k2 < 2; ++k2) {
                    u32x4 t;
                    t.x = pk2(s[2 * k2][0], s[2 * k2][1]); t.y = pk2(s[2 * k2][2], s[2 * k2][3]);
                    t.z = pk2(s[2 * k2 + 1][0], s[2 * k2 + 1][1]); t.w = pk2(s[2 * k2 + 1][2], s[2 * k2 + 1][3]);
                    pf[mt][k2] = __builtin_bit_cast(bf16x8, t);
                }
            }
#pragma unroll
            for (int k2 = 0; k2 < 2; ++k2)
#pragma unroll
                for (int dt = 0; dt < DV / 16; ++dt) {
                    const s16x4 v0 = __builtin_amdgcn_ds_read_tr16_b64_v4i16((LDS s16x4*)(Vs + vbase + (k2 * 32) * VSTR + dt * 32));
                    const s16x4 v1 = __builtin_amdgcn_ds_read_tr16_b64_v4i16((LDS s16x4*)(Vs + vbase + (k2 * 32 + 16) * VSTR + dt * 32));
                    const bf16x8 vf = __builtin_shufflevector(v0, v1, 0, 1, 2, 3, 4, 5, 6, 7);
#pragma unroll
                    for (int mt = 0; mt < MT; ++mt) o[mt][dt] = MFMA(vf, pf[mt][k2], o[mt][dt]);
                }
        }
    }
}

DEV void diff_unit(CParams& p, int l, int unit, lds_char* smem) {
    const int T = tidx(), lane = T & 63, w = T >> 6, fr = lane & 15, fq = lane >> 4;
    const int qt = 127 - (unit >> 5), bh = unit & 31, b = bh >> 2, h = bh & 3;
    const int comp = w >> 1, qrow0 = (w & 1) * 32;
    f32x4 o[2][8]; float mrow[2], lrow[2];
    bf16_t* aq = (bf16_t*)(p.ws + OFF_AQ);
    flash_core<64, 128, 128, 2, 0, false>(aq + h * 128 + comp * 64, 512, b * SEQ + qt * 64, 1, qrow0,
                                   (const bf16_t*)(p.ws + OFF_AK) + h * 128, 512, (const bf16_t*)(p.ws + OFF_AV) + h * 128, 512, b * SEQ, 1,
                                   0, qt + 1, comp * 64, 0.125f * LOG2E, qt * 64, smem, o, mrow, lrow);
    int l2 = l; asm volatile("" : "+s"(l2));
    const float linit = (l2 == 0) ? 0.2f : 0.35550906759096934f;
    float lam;
    {
        const float* lq = p.in[I_LAMQK] + l2 * 256;
        float s1 = lq[lane] * lq[64 + lane], s2 = lq[128 + lane] * lq[192 + lane];
#pragma unroll
        for (int o = 32; o >= 1; o >>= 1) { s1 += __shfl_xor(s1, o); s2 += __shfl_xor(s2, o); }
        lam = expf(s1) - expf(s2) + linit;
    }
#pragma unroll
    for (int mt = 0; mt < 2; ++mt) {
        float lt = lrow[mt]; lt += __shfl_xor(lt, 16); lt += __shfl_xor(lt, 32);
        const float inv = 1.0f / lt;
#pragma unroll
        for (int dt = 0; dt < 8; ++dt) o[mt][dt] *= inv;
    }
    __syncthreads();
    LDS float* X = (LDS float*)smem;
    if (comp == 1) {
#pragma unroll
        for (int mt = 0; mt < 2; ++mt)
#pragma unroll
            for (int dt = 0; dt < 8; ++dt) *(LDS f32x4*)(X + ((w & 1) * 32 + mt * 16 + fr) * 132 + dt * 16 + fq * 4) = o[mt][dt];
    }
    __syncthreads();
    if (comp == 0) {
        const float* g = p.in[I_SUBLN] + l * 128;
#pragma unroll
        for (int mt = 0; mt < 2; ++mt) {
            float ss = 0.f;
#pragma unroll
            for (int dt = 0; dt < 8; ++dt) {
                const f32x4 o2 = *(const LDS f32x4*)(X + ((w & 1) * 32 + mt * 16 + fr) * 132 + dt * 16 + fq * 4);
                o[mt][dt] = o[mt][dt] - lam * o2;
                ss += o[mt][dt][0] * o[mt][dt][0] + o[mt][dt][1] * o[mt][dt][1] + o[mt][dt][2] * o[mt][dt][2] + o[mt][dt][3] * o[mt][dt][3];
            }
            ss += __shfl_xor(ss, 16); ss += __shfl_xor(ss, 32);
            const float r = rsqrtf(ss * (1.0f / 128.0f) + 1e-5f) * (1.0f - linit);
            bf16_t* dst = aq + (size_t)(b * SEQ + qt * 64 + qrow0 + mt * 16 + fr) * 512 + h * 128 + fq * 4;
#pragma unroll
            for (int dt = 0; dt < 8; ++dt) {
                const f32x4 gg = *(const f32x4*)(g + dt * 16 + fq * 4);
                u32x2 v; v.x = pk2(o[mt][dt][0] * r * gg[0], o[mt][dt][1] * r * gg[1]); v.y = pk2(o[mt][dt][2] * r * gg[2], o[mt][dt][3] * r * gg[3]);
                wt_store8(dst + dt * 16, v);
            }
        }
    }
}

DEV void dil_unit(CParams& p, int pat, int unit, lds_char* smem) {
    const int T = tidx(), lane = T & 63, w = T >> 6, fr = lane & 15, fq = lane >> 4;
    const int dil = (pat == 0) ? 1 : (pat == 1) ? 4 : 16;
    const int bh = unit & 63, b = bh >> 3, head = bh & 7, pn = unit >> 6, ph = pn % dil, n = pn / dil;
    const int qrow0 = w * 32;
    f32x4 o[2][4]; float mrow[2], lrow[2];
    const int qtok0 = b * SEQ + n * 128 * dil + ph, ktok0 = b * SEQ + (n - 1) * 128 * dil + ph;
    flash_core<64, 64, 64, 2, 1, true>((const bf16_t*)(p.ws + OFF_CQ) + head * 64, 512, qtok0, dil, qrow0,
                                 (const bf16_t*)(p.ws + OFF_CK) + head * 64, 512, (const bf16_t*)(p.ws + OFF_CV) + head * 64, 512, ktok0, dil,
                                 (n == 0) ? 2 : 0, 4, 0, 0.125f * LOG2E, 0, smem, o, mrow, lrow);
    bf16_t* oc = (bf16_t*)(p.ws + OFF_OC);
    float* lsebuf = (float*)(p.ws + OFF_LSE);
#pragma unroll
    for (int mt = 0; mt < 2; ++mt) {
        float lt = lrow[mt]; lt += __shfl_xor(lt, 16); lt += __shfl_xor(lt, 32);
        const float inv = 1.0f / lt;
        float lse = (mrow[mt] + log2f(lt)) * LN2;
        const size_t tok = (size_t)qtok0 + (size_t)(qrow0 + mt * 16 + fr) * dil;
        bf16_t* dst = oc + tok * 512 + head * 64 + fq * 4;
        float wn = inv, wo = 0.f;
        if (pat > 0) {
            const float lo = lsebuf[tok * 8 + head];
            const float mxl = fmaxf(lo, lse);
            const float eo = fexp(lo - mxl), en = fexp(lse - mxl);
            const float tot = eo + en;
            wo = eo / tot; wn = inv * en / tot;
            lse = mxl + logf(tot);
        }
#pragma unroll
        for (int dt = 0; dt < 4; ++dt) {
            f32x4 v = o[mt][dt] * wn;
            if (pat > 0) { const u32x2 old = *(const u32x2*)(dst + dt * 16); v[0] += wo * bflo(old.x); v[1] += wo * bfhi(old.x); v[2] += wo * bflo(old.y); v[3] += wo * bfhi(old.y); }
            u32x2 r; r.x = pk2(v[0], v[1]); r.y = pk2(v[2], v[3]);
            wt_store8(dst + dt * 16, r);
        }
        if (pat < 2 && fq == 0) wt_store4f(&lsebuf[tok * 8 + head], lse);
    }
}

DEV void xattn_unit(CParams& p, int l, int unit, lds_char* smem) {
    const int T = tidx(), lane = T & 63, w = T >> 6, fr = lane & 15, fq = lane >> 4;
    const int h = unit & 3, tok0 = (unit >> 2) * 64, b = tok0 / SEQ;
    f32x4 o[1][16]; float mrow[1], lrow[1];
    bf16_t* qx = (bf16_t*)(p.ws + OFF_QX);
    const bf16_t* kv = (const bf16_t*)(p.ws + OFF_MEMKV) + (size_t)l * 2048 * 2048;
    flash_core<256, 256, 256, 1, 2, false>(qx + h * 256, 1024, tok0, 1, w * 16, kv + h * 256, 2048, kv + 1024 + h * 256, 2048, b * 256, 1,
                                    0, 4, 0, 0.0625f * LOG2E, 0, smem, o, mrow, lrow);
    float lt = lrow[0]; lt += __shfl_xor(lt, 16); lt += __shfl_xor(lt, 32);
    const float inv = 1.0f / lt;
    bf16_t* dst = qx + (size_t)(tok0 + w * 16 + fr) * 1024 + h * 256 + fq * 4;
#pragma unroll
    for (int dt = 0; dt < 16; ++dt) {
        u32x2 r; r.x = pk2(o[0][dt][0] * inv, o[0][dt][1] * inv); r.y = pk2(o[0][dt][2] * inv, o[0][dt][3] * inv);
        wt_store8(dst + dt * 16, r);
    }
}

DEV float neg_expm1(float x) {
    if (x > -0.3f) { float r = 1.0f / 720.0f; r = r * x + 1.0f / 120.0f; r = r * x + 1.0f / 24.0f; r = r * x + 1.0f / 6.0f; r = r * x + 0.5f; r = r * x + 1.0f; return -(r * x); }
    return 1.0f - fexp(x);
}
DEV float gelu_tanh(float x) {
    const float y = 0.7978845608028654f * (x + 0.044715f * x * x * x);
    const float t = 1.0f - 2.0f / (fexp(2.0f * y) + 1.0f);
    return 0.5f * x * (1.0f + t);
}
DEV void lru_unit(CParams& p, int l, int unit, int pass, lds_char* smem) {
    const int T = tidx(), lane = T & 63, w = T >> 6, fr = lane & 15, fq = lane >> 4;
    const int grp = unit & 3, c = (unit >> 2) & 127, b = unit >> 9;
    const int nb = grp * 4 + w, ch0 = nb * 64;
    lds_char* Xs = smem + w * 19456;
    lds_char* XCs = Xs + 9728;
    const bf16_t* rx = (const bf16_t*)(p.ws + OFF_RX);
    bf16_t* rg = (bf16_t*)(p.ws + OFF_RG);
    __syncthreads();
    for (int q = lane; q < 536; q += 64) {
        const int r = q >> 3, ch = q & 7, s = c * 64 + r - 3;
        u32x4 v = (u32x4){0u, 0u, 0u, 0u};
        if (s >= 0) v = *(const u32x4*)(rx + ((size_t)b * SEQ + s) * 1024 + ch0 + ch * 8);
        *(LDS u32x4*)(Xs + r * 144 + ch * 16) = v;
    }
    __syncthreads();
    {
        const int ch = lane & 7;
        const float* cw = p.in[I_CONVW] + (size_t)l * 4096 + ch0 + ch * 8;
        const float* cb = p.in[I_CONVB] + (size_t)l * 1024 + ch0 + ch * 8;
        float wv[4][8], bv[8];
#pragma unroll
        for (int e = 0; e < 8; ++e) { bv[e] = cb[e];
#pragma unroll
            for (int tp = 0; tp < 4; ++tp) wv[tp][e] = cw[tp * 1024 + e]; }
#pragma unroll
        for (int it = 0; it < 8; ++it) {
            const int t = it * 8 + (lane >> 3);
            float a[8];
#pragma unroll
            for (int e = 0; e < 8; ++e) a[e] = bv[e];
#pragma unroll
            for (int tp = 0; tp < 4; ++tp) {
                const u32x4 xv = *(const LDS u32x4*)(Xs + (t + tp) * 144 + ch * 16);
                a[0] += bflo(xv.x) * wv[tp][0]; a[1] += bfhi(xv.x) * wv[tp][1]; a[2] += bflo(xv.y) * wv[tp][2]; a[3] += bfhi(xv.y) * wv[tp][3];
                a[4] += bflo(xv.z) * wv[tp][4]; a[5] += bfhi(xv.z) * wv[tp][5]; a[6] += bflo(xv.w) * wv[tp][6]; a[7] += bfhi(xv.w) * wv[tp][7];
            }
            u32x4 ov; ov.x = pk2(a[0], a[1]); ov.y = pk2(a[2], a[3]); ov.z = pk2(a[4], a[5]); ov.w = pk2(a[6], a[7]);
            *(LDS u32x4*)(XCs + t * 144 + ch * 16) = ov;
        }
    }
    __syncthreads();
    const bf16_t* gw = (const bf16_t*)(p.ws + OFF_WT) + (size_t)l * WL_ELEMS + W_GW;
    bf16x8 gf[2][4][2];
#pragma unroll
    for (int g = 0; g < 2; ++g)
#pragma unroll
        for (int nt = 0; nt < 4; ++nt)
#pragma unroll
            for (int ks = 0; ks < 2; ++ks) gf[g][nt][ks] = *(const bf16x8*)(gw + ((size_t)(g * 16 + nb) * 64 + nt * 16 + fr) * 64 + ks * 32 + fq * 8);
    float sp[4], gb0[4], gb1[4], hin[4], atot[4];
#pragma unroll
    for (int nt = 0; nt < 4; ++nt) {
        const int ch = ch0 + nt * 16 + fr;
        const float lam = p.in[I_LAMBDA][l * 1024 + ch];
        const float x = fexp(-lam);
        sp[nt] = (x < 0.03f) ? x * (1.0f + x * (-0.5f + x * (1.0f / 3.0f + x * (-0.25f + x * 0.2f)))) : logf(1.0f + x);
        gb0[nt] = p.in[I_GATEB][l * 2048 + ch]; gb1[nt] = p.in[I_GATEB][l * 2048 + 1024 + ch];
        atot[nt] = 1.0f;
        hin[nt] = (pass == 1) ? ((const float*)(p.ws + OFF_LH))[((size_t)b * 128 + c) * 1024 + ch] : 0.0f;
    }
    for (int m = 0; m < 4; ++m) {
        f32x4 ar[4], ai[4];
#pragma unroll
        for (int nt = 0; nt < 4; ++nt) { ar[nt] = (f32x4){0.f, 0.f, 0.f, 0.f}; ai[nt] = (f32x4){0.f, 0.f, 0.f, 0.f}; }
#pragma unroll
        for (int ks = 0; ks < 2; ++ks) {
            const bf16x8 xa = *(const LDS bf16x8*)(XCs + (m * 16 + fr) * 144 + (ks * 32 + fq * 8) * 2);
#pragma unroll
            for (int nt = 0; nt < 4; ++nt) { ar[nt] = MFMA(xa, gf[0][nt][ks], ar[nt]); ai[nt] = MFMA(xa, gf[1][nt][ks], ai[nt]); }
        }
#pragma unroll
        for (int nt = 0; nt < 4; ++nt) {
            float Pj[4], Hj[4]; float P = 1.0f, Hh = 0.0f;
#pragma unroll
            for (int j = 0; j < 4; ++j) {
                const int tk = m * 16 + fq * 4 + j;
                const float xc = bf2f(*(const LDS bf16_t*)(XCs + tk * 144 + (nt * 16 + fr) * 2));
                const float r = sigmoidf_(ar[nt][j] + gb0[nt]), ig = sigmoidf_(ai[nt][j] + gb1[nt]);
                const float la = -8.0f * r * sp[nt];
                const float a = fexp(la);
                const float u = sqrtf(neg_expm1(2.0f * la)) * (ig * xc);
                Hh = a * Hh + u; P *= a; Pj[j] = P; Hj[j] = Hh;
            }
            float A1 = P, H1 = Hh;
            { const float ta = __shfl_up(A1, 16), th = __shfl_up(H1, 16); if (fq >= 1) { H1 = A1 * th + H1; A1 = A1 * ta; } }
            { const float ta = __shfl_up(A1, 32), th = __shfl_up(H1, 32); if (fq >= 2) { H1 = A1 * th + H1; A1 = A1 * ta; } }
            float Ea = __shfl_up(A1, 16), Eh = __shfl_up(H1, 16);
            if (fq == 0) { Ea = 1.0f; Eh = 0.0f; }
            const float Ta = __shfl(A1, 48 + fr), Th = __shfl(H1, 48 + fr);
            if (pass == 1) {
                const float h0 = Ea * hin[nt] + Eh;
#pragma unroll
                for (int j = 0; j < 4; ++j) {
                    const int tk = m * 16 + fq * 4 + j;
                    const float hv = Pj[j] * h0 + Hj[j];
                    bf16_t* gp = rg + ((size_t)b * SEQ + c * 64 + tk) * 1024 + ch0 + nt * 16 + fr;
                    const float gv = bf2f(*gp);
                    wt_store2(gp, (bf16_t)(pk2(hv * gelu_tanh(gv), 0.f) & 0xffffu));
                }
            }
            hin[nt] = Ta * hin[nt] + Th; atot[nt] *= Ta;
        }
    }
    if (pass == 0 && fq == 0) {
#pragma unroll
        for (int nt = 0; nt < 4; ++nt) {
            const size_t o = ((size_t)b * 128 + c) * 1024 + ch0 + nt * 16 + fr;
            wt_store4f((float*)(p.ws + OFF_LA) + o, atot[nt]); wt_store4f((float*)(p.ws + OFF_LH) + o, hin[nt]);
        }
    }
}
DEV void lru_carry(CParams& p) {
    float* LA = (float*)(p.ws + OFF_LA); float* LH = (float*)(p.ws + OFF_LH);
    for (int i = blockIdx.x * 256 + tidx(); i < NB * 1024; i += gridDim.x * 256) {
        const int b = i >> 10, ch = i & 1023;
        float carry = 0.f;
        for (int c = 0; c < 128; ++c) {
            const size_t o = ((size_t)b * 128 + c) * 1024 + ch;
            const float a = LA[o], h = LH[o];
            wt_store4f(&LH[o], carry); carry = a * carry + h;
        }
    }
}

DEV void phase_mix(CParams& p, int l, int which, lds_char* smem) {
    const int G = gridDim.x, bid = blockIdx.x;
    if (which == 0) {
        for (int u = bid; u < 4096; u += G) diff_unit(p, l, u, smem);
        for (int u = bid; u < 4096; u += G) dil_unit(p, 0, u, smem);
        for (int u = bid; u < 4096; u += G) lru_unit(p, l, u, 0, smem);
    } else if (which == 1) {
        lru_carry(p);
        for (int u = bid; u < 4096; u += G) dil_unit(p, 1, u, smem);
    } else {
        for (int u = bid; u < 4096; u += G) dil_unit(p, 2, u, smem);
#ifndef DBG_NO_LRU1
        for (int u = bid; u < 4096; u += G) lru_unit(p, l, u, 1, smem);
#endif
    }
}

DEV void phase_merge(CParams& p, int l, lds_char* smem) {
    const int G = gridDim.x, bid = blockIdx.x;
    const bf16_t* xb = (const bf16_t*)(p.ws + OFF_XB);
    const bf16_t* WT = (const bf16_t*)(p.ws + OFF_WT) + (size_t)l * WL_ELEMS;
    for (int u = bid; u < 512 * 8; u += G) {
        const int m0 = (u >> 3) * 128, n0 = (u & 7) * 128;
        f32x4 accM[4][4]; zero_acc<4>(accM);
#pragma unroll 1
        for (int i = 0; i < 3; ++i) {
            f32x4 acc[4][4]; zero_acc<4>(acc);
            gemm_acc<4>(acc, xb, 1024, m0, WT + W_IN + (size_t)(5120 + i * 1024) * 1024, 1024, n0, 1024, smem);
            unsigned gp[4][4][2];
#pragma unroll
            for (int m = 0; m < 4; ++m)
#pragma unroll
                for (int n = 0; n < 4; ++n) { gp[m][n][0] = pk2(sigmoidf_(acc[m][n][0]), sigmoidf_(acc[m][n][1])); gp[m][n][1] = pk2(sigmoidf_(acc[m][n][2]), sigmoidf_(acc[m][n][3])); }
            zero_acc<4>(acc);
            const bf16_t* A = (i == 0) ? (const bf16_t*)(p.ws + OFF_AQ) : (i == 1) ? (const bf16_t*)(p.ws + OFF_RG) : (const bf16_t*)(p.ws + OFF_OC);
            const int Ki = (i == 1) ? 1024 : 512;
            const bf16_t* Bt = WT + ((i == 0) ? W_BRA : (i == 1) ? W_BRB : W_BRC);
            gemm_acc<4>(acc, A, Ki, m0, Bt, Ki, n0, Ki, smem);
#pragma unroll
            for (int m = 0; m < 4; ++m)
#pragma unroll
                for (int n = 0; n < 4; ++n) {
                    accM[m][n][0] += bflo(gp[m][n][0]) * acc[m][n][0]; accM[m][n][1] += bfhi(gp[m][n][0]) * acc[m][n][1];
                    accM[m][n][2] += bflo(gp[m][n][1]) * acc[m][n][2]; accM[m][n][3] += bfhi(gp[m][n][1]) * acc[m][n][3];
                }
        }
        epi_bf16<4>(accM, (bf16_t*)(p.ws + OFF_MERGED), 1024, m0, n0);
    }
}
DEV void phase_gemm_res(CParams& p, const bf16_t* A, int K, const bf16_t* Bt, const float* res, lds_char* smem) {
    const int G = gridDim.x, bid = blockIdx.x;
    for (int u = bid; u < 512 * 8; u += G) {
        const int m0 = (u >> 3) * 128, n0 = (u & 7) * 128;
        f32x4 acc[4][4]; zero_acc<4>(acc);
        gemm_acc<4>(acc, A, K, m0, Bt, K, n0, K, smem);
        epi_res(acc, res, p.out, m0, n0);
    }
}
#ifndef XQ_COH
#define XQ_COH false
#endif
DEV void phase_xq(CParams& p, int l, lds_char* smem) {
    const int G = gridDim.x, bid = blockIdx.x;
    const bf16_t* WT = (const bf16_t*)(p.ws + OFF_WT) + (size_t)l * WL_ELEMS;
#ifdef DBG_XQ_DELAY
    { const unsigned long long t0 = __builtin_amdgcn_s_memrealtime(); while (__builtin_amdgcn_s_memrealtime() - t0 < 50000ull) __builtin_amdgcn_s_sleep(8); }
#endif
#ifdef DBG_XQ_A_MERGED
    const bf16_t* xb = (const bf16_t*)(p.ws + OFF_MERGED);
#elif defined(DBG_XB2)
    const bf16_t* xb = (const bf16_t*)(p.ws + 984 * MiB);
#elif defined(DBG_XQ_F32)
    const bf16_t* xb = (const bf16_t*)p.out;
#else
    const bf16_t* xb = (const bf16_t*)(p.ws + OFF_XB);
#endif
#ifndef DBG_XQW
#define DBG_XQW W_XQ
#endif
    const bf16_t* Wq = WT + DBG_XQW;
#ifdef DBG_XB2
    bf16_t* qx = (bf16_t*)(p.ws + OFF_QX);
    for (int u = bid; u < 128 * 8; u += G) {
#elif defined(DBG_QX_ALT)
    bf16_t* qx = (bf16_t*)(p.ws + 984 * MiB);
    for (int u = bid; u < 128 * 8; u += G) {
#else
    bf16_t* qx = (bf16_t*)(p.ws + OFF_QX);
    for (int u = bid; u < 512 * 8; u += G) {
#endif
#ifdef DBG_XQ_MAP2
        const int m0 = (u & 511) * 128, n0 = (u >> 9) * 128;
#else
        const int m0 = (u >> 3) * 128, n0 = (u & 7) * 128;
#endif
        f32x4 acc[4][4]; zero_acc<4>(acc);
        gemm_acc<4, XQ_COH>(acc, xb, 1024, m0, Wq, 1024, n0, 1024, smem);
        epi_bf16<4>(acc, qx, 1024, m0, n0);
    }
}
DEV void phase_memkv(CParams& p, int l, lds_char* smem) {
    const int G = gridDim.x, bid = blockIdx.x;
    const bf16_t* WT = (const bf16_t*)(p.ws + OFF_WT) + (size_t)l * WL_ELEMS;
    for (int t = bid; t < 256; t += G) {
        f32x4 acc[4][4]; zero_acc<4>(acc);
        const int m0 = (t >> 4) * 128, n0 = (t & 15) * 128;
        gemm_acc<4>(acc, (const bf16_t*)(p.ws + OFF_MEMB), 1024, m0, WT + W_XKV, 1024, n0, 1024, smem);
        epi_bf16<4>(acc, (bf16_t*)(p.ws + OFF_MEMKV) + (size_t)l * 2048 * 2048, 2048, m0, n0);
    }
}
DEV void phase_up(CParams& p, int l, lds_char* smem) {
    const int G = gridDim.x, bid = blockIdx.x;
    const bf16_t* WT = (const bf16_t*)(p.ws + OFF_WT) + (size_t)l * WL_ELEMS;
    const bf16_t* xb = (const bf16_t*)(p.ws + OFF_XB);
    for (int u = bid; u < 512 * 22; u += G) {
        const int m0 = (u / 22) * 128, n0 = (u % 22) * 128;
        f32x4 acc[4][4]; zero_acc<4>(acc);
        gemm_acc<4>(acc, xb, 1024, m0, WT + W_UP, 1024, n0, 1024, smem);
        unsigned gp[4][4][2];
#pragma unroll
        for (int m = 0; m < 4; ++m)
#pragma unroll
            for (int n = 0; n < 4; ++n) {
                f32x4 g = acc[m][n];
#pragma unroll
                for (int j = 0; j < 4; ++j) g[j] = g[j] * sigmoidf_(g[j]);
                gp[m][n][0] = pk2(g[0], g[1]); gp[m][n][1] = pk2(g[2], g[3]);
            }
        zero_acc<4>(acc);
        gemm_acc<4>(acc, xb, 1024, m0, WT + W_UP + (size_t)2816 * 1024, 1024, n0, 1024, smem);
#pragma unroll
        for (int m = 0; m < 4; ++m)
#pragma unroll
            for (int n = 0; n < 4; ++n) {
                acc[m][n][0] *= bflo(gp[m][n][0]); acc[m][n][1] *= bfhi(gp[m][n][0]); acc[m][n][2] *= bflo(gp[m][n][1]); acc[m][n][3] *= bfhi(gp[m][n][1]);
            }
        epi_bf16<4>(acc, (bf16_t*)(p.ws + OFF_HMID), 2816, m0, n0);
    }
}

DEV void phase_ln(CParams& p, const float* g, const float* bta) {
    const int lane = tidx() & 63, w = tidx() >> 6;
    f32x4 gv[4], bv[4];
#pragma unroll
    for (int i = 0; i < 4; ++i) { gv[i] = *(const f32x4*)(g + i * 256 + lane * 4); bv[i] = *(const f32x4*)(bta + i * 256 + lane * 4); }
    for (int row = blockIdx.x * 4 + w; row < NTOK; row += gridDim.x * 4) {
        float* xr = p.out + (size_t)row * DM;
        f32x4 v[4]; float s = 0.f;
#pragma unroll
        for (int i = 0; i < 4; ++i) { v[i] = *(const f32x4*)(xr + i * 256 + lane * 4); s += v[i][0] + v[i][1] + v[i][2] + v[i][3]; }
#pragma unroll
        for (int o = 32; o >= 1; o >>= 1) s += __shfl_xor(s, o);
        const float mean = s * (1.0f / 1024.0f);
        float q = 0.f;
#pragma unroll
        for (int i = 0; i < 4; ++i) { v[i] = v[i] - mean; q += v[i][0] * v[i][0] + v[i][1] * v[i][1] + v[i][2] * v[i][2] + v[i][3] * v[i][3]; }
#pragma unroll
        for (int o = 32; o >= 1; o >>= 1) q += __shfl_xor(q, o);
        const float rstd = rsqrtf(q * (1.0f / 1024.0f) + 1e-5f);
        bf16_t* xbr = (bf16_t*)(p.ws + OFF_XB) + (size_t)row * DM;
#pragma unroll
        for (int i = 0; i < 4; ++i) {
            f32x4 y = v[i] * rstd * gv[i] + bv[i];
#ifdef DBG_SANITIZE
            for (int e = 0; e < 4; ++e) if (!(fabsf(y[e]) < 1e30f)) y[e] = 0.f;
#endif
            wt_store16(xr + i * 256 + lane * 4, __builtin_bit_cast(u32x4, y));
            u32x2 r; r.x = pk2(y[0], y[1]); r.y = pk2(y[2], y[3]);
            wt_store8(xbr + i * 256 + lane * 4, r);
#ifdef DBG_XB2
            if (row < 16384) wt_store8((bf16_t*)(p.ws + 984 * MiB) + (size_t)row * DM + i * 256 + lane * 4, r);
#endif
        }
    }
}

#ifdef DBG_PH_HI
#define EN(k) ((k) < DBG_PH_HI - 1)
#else
#define EN(k) 1
#endif
constexpr int PH_PER_LAYER = 14, N_PHASES = 1 + 2 * PH_PER_LAYER;
DEV void run_phase(CParams& p, int ph, lds_char* smem) {
    if (ph == 0) { phase_prep(p, smem); return; }
    const int l = (ph - 1) / PH_PER_LAYER, k = (ph - 1) % PH_PER_LAYER;
    const bf16_t* WT = (const bf16_t*)(p.ws + OFF_WT) + (size_t)l * WL_ELEMS;
    switch (k) {
        case 0:
#if EN(0)
            phase_u(p, l, smem);
#ifdef DBG_XQ_IN_P1
            phase_xq(p, l, smem);
#endif
#endif
            break;
        case 1:
#if EN(1)
            phase_mix(p, l, 0, smem);
#endif
            break;
        case 2:
#if EN(2)
            phase_mix(p, l, 1, smem);
#endif
            break;
        case 3:
#if EN(3)
            phase_mix(p, l, 2, smem);
#endif
            break;
        case 4:
#if EN(4)
            phase_merge(p, l, smem);
#endif
            break;
        case 5:
#if EN(5)
            phase_gemm_res(p, (const bf16_t*)(p.ws + OFF_MERGED), 1024, WT + W_OUT, (l == 0) ? p.in[I_X] : p.out, smem);
#endif
            break;
        case 6:
#if EN(6) && !defined(DBG_SKIP_LN1)
            phase_ln(p, p.in[I_LN1G] + l * 1024, p.in[I_LN1B] + l * 1024);
#endif
            break;
        case 7:
#if EN(7)
            phase_xq(p, l, smem);
            phase_memkv(p, l, smem);
#endif
            break;
        case 8:
#if EN(8)
            for (int u = blockIdx.x; u < 4096; u += gridDim.x) xattn_unit(p, l, u, smem);
#endif
            break;
        case 9:
#if EN(9)
            phase_gemm_res(p, (const bf16_t*)(p.ws + OFF_QX), 1024, WT + W_XO, p.out, smem);
#endif
            break;
        case 10:
#if EN(10)
            phase_ln(p, p.in[I_LN2G] + l * 1024, p.in[I_LN2B] + l * 1024);
#endif
            break;
        case 11:
#if EN(11)
            phase_up(p, l, smem);
#endif
            break;
        case 12:
#if EN(12)
            phase_gemm_res(p, (const bf16_t*)(p.ws + OFF_HMID), 2816, WT + W_DOWN, p.out, smem);
#endif
            break;
        default:
#if EN(13)
            phase_ln(p, p.in[I_LN3G] + l * 1024, p.in[I_LN3B] + l * 1024);
#endif
            break;
    }
}

template <int K>
__global__ void __launch_bounds__(256, 2) phase_kernel(Params p, int l) {
    extern __shared__ __attribute__((aligned(16))) char smem_raw[];
    lds_char* smem = (lds_char*)smem_raw;
    CParams* kp = (CParams*)__builtin_amdgcn_kernarg_segment_ptr();
    CParams& q = *kp;
    const bf16_t* WT = (const bf16_t*)(q.ws + OFF_WT) + (size_t)l * WL_ELEMS;
    if (K == 99) phase_prep(q, smem);
    else if (K == 0) phase_u(q, l, smem);
    else if (K == 1) phase_mix(q, l, 0, smem);
    else if (K == 2) phase_mix(q, l, 1, smem);
    else if (K == 3) phase_mix(q, l, 2, smem);
    else if (K == 4) phase_merge(q, l, smem);
    else if (K == 5) phase_gemm_res(q, (const bf16_t*)(q.ws + OFF_MERGED), 1024, WT + W_OUT, (l == 0) ? q.in[I_X] : q.out, smem);
    else if (K == 6) phase_ln(q, q.in[I_LN1G] + l * 1024, q.in[I_LN1B] + l * 1024);
    else if (K == 7) phase_xq(q, l, smem);
    else if (K == 14) phase_memkv(q, l, smem);
    else if (K == 8) { for (int u = blockIdx.x; u < 4096; u += gridDim.x) xattn_unit(q, l, u, smem); }
    else if (K == 9) phase_gemm_res(q, (const bf16_t*)(q.ws + OFF_QX), 1024, WT + W_XO, q.out, smem);
    else if (K == 10) phase_ln(q, q.in[I_LN2G] + l * 1024, q.in[I_LN2B] + l * 1024);
    else if (K == 11) phase_up(q, l, smem);
    else if (K == 12) phase_gemm_res(q, (const bf16_t*)(q.ws + OFF_HMID), 2816, WT + W_DOWN, q.out, smem);
    else phase_ln(q, q.in[I_LN3G] + l * 1024, q.in[I_LN3B] + l * 1024);
}
#ifdef DBG_SPLIT_STOP
__global__ void __launch_bounds__(256, 2) dump_kernel(Params p) {
    const size_t NW = DBG_NW;
    for (size_t i = (size_t)blockIdx.x * 256 + threadIdx.x; i < 3 * NW; i += (size_t)gridDim.x * 256) {
        const size_t r = i / NW, j = i % NW;
        const size_t off = (r == 0) ? (size_t)DBG_DUMP_OFF : (r == 1) ? (size_t)DBG_DUMP_OFF2 : (size_t)DBG_DUMP_OFF3;
#ifdef DBG_DUMP_F32
        float a0 = p.out[2 * i], a1 = p.out[2 * i + 1];
#else
        const unsigned v = ((const unsigned*)(p.ws + off))[j]; float a0 = bflo(v), a1 = bfhi(v);
#endif
        const float mk = (r == 0) ? 1.0e3f : (r == 1) ? 1.0e5f : 1.0e7f;
        if (!(fabsf(a0) < 1e30f)) a0 = mk; if (!(fabsf(a1) < 1e30f)) a1 = mk;
        p.out[2 * i] = a0; p.out[2 * i + 1] = a1;
    }
}
#endif
template <int K>
static void launch_phase(const Params& p, int l, int grid, hipStream_t stream) {
    hipFuncSetAttribute((const void*)phase_kernel<K>, hipFuncAttributeMaxDynamicSharedMemorySize, SMEM_BYTES);
    hipLaunchKernelGGL(phase_kernel<K>, dim3(grid), dim3(256), SMEM_BYTES, stream, p, l);
}
__global__ void __launch_bounds__(256, 2) mega(Params p) {
    extern __shared__ __attribute__((aligned(16))) char smem_raw[];
    lds_char* smem = (lds_char*)smem_raw;
    cg::grid_group grid = cg::this_grid();
    const int ph_lo = p.ph_lo, ph_hi = p.ph_hi;
    unsigned nbar = 0;
    if (ph_lo < 0) grid.sync();
    for (int ph = ph_lo; ph < ph_hi; ++ph) {
        CParams* kp = (CParams*)__builtin_amdgcn_kernarg_segment_ptr();
        asm volatile("" : "+s"(kp));
#ifdef DBG_SELFCHECK
        if (ph == DBG_PH_HI + 1) {
            if (blockIdx.x == 0 && tidx() == 0) {
                const unsigned c = __hip_atomic_load((unsigned*)(kp->ws + 64), __ATOMIC_RELAXED, __HIP_MEMORY_SCOPE_AGENT);
                const float b = (float)((c + 16384u) / 32768u);
                kp->out[0] = 1.0e6f * b + 7.0e5f * (float)(c < 1000000u ? c : 999999u) / 1.0e6f * 0.f;
            }
        } else
#endif
#if defined(DBG_DUMP_OFF) && defined(DBG_PH_HI)
        if (ph == DBG_PH_HI) {
#ifndef DBG_NW
#define DBG_NW 10485760
#endif
#ifndef DBG_COLEXPR
#define DBG_COLEXPR (((int)(i & 15) * 61 + (int)(row & 63)) % DBG_NCOL)
#endif
#ifdef DBG_SELFCHECK
            {
                const bf16_t* Ap = (const bf16_t*)(kp->ws + DBG_A_OFF);
                const bf16_t* Wp = (const bf16_t*)(kp->ws + OFF_WT) + DBG_W_OFF;
                const bf16_t* Cp = (const bf16_t*)(kp->ws + DBG_C_OFF);
                for (size_t i = (size_t)blockIdx.x * 256 + tidx(); i < (size_t)DBG_ROWS * 16; i += (size_t)gridDim.x * 256) {
                    const size_t row = i >> 4; const int col = DBG_COLEXPR;
                    float acc = 0.f;
                    for (int k = 0; k < 1024; ++k) {
#ifdef DBG_A_FROM_X
                        const float av = bflo(pk2(kp->in[I_X][row * 1024 + k], 0.f));
#elif defined(DBG_A_FROM_OUT)
                        const float av = bflo(pk2(kp->out[row * 1024 + k], 0.f));
#else
                        const float av = bf2f(Ap[row * 1024 + k]);
#endif
                        acc += av * bf2f(Wp[(size_t)col * 1024 + k]); }
                    const float st = bf2f(Cp[row * DBG_LDC + col]);
                    if (!(fabsf(acc - st) <= 0.02f + 0.02f * fabsf(acc))) atomicAdd((unsigned*)(kp->ws + 64), 1u);
                }
            }
#else
            const size_t NW = DBG_NW;
            for (size_t i = (size_t)blockIdx.x * 256 + tidx(); i < 3 * NW; i += (size_t)gridDim.x * 256) {
                const size_t r = i / NW, j = i % NW;
                const size_t off = (r == 0) ? (size_t)DBG_DUMP_OFF : (r == 1) ? (size_t)DBG_DUMP_OFF2 : (size_t)DBG_DUMP_OFF3;
                const unsigned v = ((const unsigned*)(kp->ws + off))[j]; { float a0 = bflo(v), a1 = bfhi(v); if (!(fabsf(a0) < 1e30f)) a0 = 12345.0f; if (!(fabsf(a1) < 1e30f)) a1 = 12345.0f; kp->out[2 * i] = a0; kp->out[2 * i + 1] = a1; }
            }
#endif
        } else
#endif
        run_phase(*kp, ph, smem);
        if (ph + 1 < ph_hi) {
#ifdef DBG_SKEW
            if ((blockIdx.x & 15) == 3) { const unsigned long long t0 = __builtin_amdgcn_s_memrealtime(); while (__builtin_amdgcn_s_memrealtime() - t0 < 30000ull) __builtin_amdgcn_s_sleep(8); }
#endif
            __builtin_amdgcn_fence(__ATOMIC_RELEASE, "agent");
            __syncthreads();
            ++nbar;
            if (tidx() == 0) {
                unsigned* ctr = (unsigned*)kp->ws;
                __hip_atomic_fetch_add(ctr, 1u, __ATOMIC_RELAXED, __HIP_MEMORY_SCOPE_AGENT);
                const unsigned target = nbar * gridDim.x;
                while (__hip_atomic_load(ctr, __ATOMIC_RELAXED, __HIP_MEMORY_SCOPE_AGENT) < target) __builtin_amdgcn_s_sleep(2);
            }
            __syncthreads();
            __builtin_amdgcn_fence(__ATOMIC_ACQUIRE, "agent");
        }
    }
}

extern "C" void kernel_launch(void* const* d_in, const int* in_sizes, int n_in, void* d_out, int out_size, void* d_ws, size_t ws_size, hipStream_t stream) {
    static int grid_blocks = 0;
    hipFuncSetAttribute((const void*)mega, hipFuncAttributeMaxDynamicSharedMemorySize, SMEM_BYTES);
    if (!grid_blocks) {
        int dev = 0, cus = 0, per_cu = 0;
        hipGetDevice(&dev);
        hipDeviceGetAttribute(&cus, hipDeviceAttributeMultiprocessorCount, dev);
        hipOccupancyMaxActiveBlocksPerMultiprocessor(&per_cu, mega, 256, SMEM_BYTES);
        if (per_cu < 1) per_cu = 1;
        if (per_cu > 2) per_cu = 2;
        grid_blocks = cus * per_cu;
    }
    hipMemsetAsync(d_ws, 0, 256, stream);
#ifdef DBG_SELFCHECK
    hipMemsetAsync(d_out, 0, 256, stream);
#endif
    Params p{};
    for (int i = 0; i < 25; ++i) p.in[i] = (const float*)d_in[i];
    p.out = (float*)d_out; p.ws = (char*)d_ws; p.ph_lo = 0; p.ph_hi = N_PHASES;
#ifdef DBG_PH_HI
#ifdef DBG_SELFCHECK
    p.ph_hi = DBG_PH_HI + 2;
#else
    p.ph_hi = DBG_PH_HI + 1;
#endif
#endif
    if (ws_size < 980 * MiB) return;
#if defined(MK_SPLIT)
    hipError_t e = hipSuccess;
    launch_phase<99>(p, 0, grid_blocks, stream);
    int nrun = 0;
#ifdef DBG_SPLIT_STOP
    const int nmax = DBG_SPLIT_STOP;
#else
    const int nmax = 30;
#endif
#define LP(K) if (nrun++ < nmax) launch_phase<K>(p, l, grid_blocks, stream)
    for (int l = 0; l < 2; ++l) {
        LP(0); LP(1); LP(2); LP(3); LP(4); LP(5); LP(6); LP(7); LP(14); LP(8); LP(9); LP(10); LP(11); LP(12); LP(13);
    }
#ifdef DBG_SPLIT_STOP
    hipLaunchKernelGGL(dump_kernel, dim3(grid_blocks), dim3(256), 0, stream, p);
#endif
#elif defined(MK_MULTI)
    hipError_t e = hipSuccess;

    const int nph = p.ph_hi;
    for (int ph = 0; ph < nph; ++ph) {
        p.ph_lo = ph; p.ph_hi = ph + 1;
        hipLaunchKernelGGL(mega, dim3(grid_blocks), dim3(256), SMEM_BYTES, stream, p);
    }
#else
    void* args[] = {&p};
    hipError_t e = hipLaunchCooperativeKernel((void*)mega, dim3(grid_blocks), dim3(256), args, SMEM_BYTES, stream);
#endif
    if (e != hipSuccess) fprintf(stderr, "cooperative launch failed: %s (grid %d)\n", hipGetErrorString(e), grid_blocks);
}
```

```cpp
#include <hip/hip_runtime.h>
#include <hip/hip_cooperative_groups.h>
#include <cstdio>
#include <cstdint>
namespace cg = cooperative_groups;

typedef unsigned short bf16_t;
typedef short bf16x8 __attribute__((ext_vector_type(8)));
typedef short s16x4 __attribute__((ext_vector_type(4)));
typedef float f32x4 __attribute__((ext_vector_type(4)));
typedef unsigned u32x4 __attribute__((ext_vector_type(4)));
typedef unsigned u32x2 __attribute__((ext_vector_type(2)));
#define LDS __attribute__((address_space(3)))
typedef LDS char lds_char;
#define DEV __device__ __forceinline__

constexpr int SEQ = 8192, NB = 8, DM = 1024, NTOK = NB * SEQ;
constexpr int SMEM_BYTES = 77824;
constexpr float ALPHA = 1.41421356237309515f;
constexpr float LOG2E = 1.44269504088896341f;
constexpr float LN2 = 0.69314718055994531f;

constexpr size_t MiB = 1048576;
constexpr size_t WL_ELEMS = 24510464;
constexpr size_t OFF_WT = 1 * MiB;
constexpr size_t OFF_MEMB = 100 * MiB;
constexpr size_t OFF_MEMKV = 964 * MiB;
constexpr size_t OFF_XB = 120 * MiB;
constexpr size_t OFF_AQ = 248 * MiB, OFF_AK = 312 * MiB, OFF_AV = 376 * MiB, OFF_RX = 440 * MiB, OFF_RG = 568 * MiB,
                 OFF_CQ = 696 * MiB, OFF_CK = 760 * MiB, OFF_CV = 824 * MiB, OFF_OC = 888 * MiB, OFF_LSE = 952 * MiB,
                 OFF_LA = 954 * MiB, OFF_LH = 958 * MiB;
constexpr size_t OFF_MERGED = OFF_RX, OFF_QX = OFF_AK, OFF_HMID = OFF_AQ;
constexpr size_t W_IN = 0, W_BRA = 8388608, W_BRB = 8912896, W_BRC = 9961472, W_OUT = 10485760, W_XQ = 11534336,
                 W_XKV = 12582912, W_XO = 14680064, W_UP = 15728640, W_DOWN = 21495808, W_GW = 24379392;

struct Params {
    const float* in[25];
    float* out;
    char* ws;
    int ph_lo, ph_hi;
};
typedef const __attribute__((address_space(4))) Params CParams;
enum { I_X = 0, I_MEM, I_WIN, I_LAMQK, I_SUBLN, I_CONVW, I_CONVB, I_GATEW, I_GATEB, I_LAMBDA, I_BRA, I_BRB, I_BRC, I_WOUT,
       I_LN1G, I_LN1B, I_XQ, I_XKV, I_XO, I_LN2G, I_LN2B, I_WUP, I_WDOWN, I_LN3G, I_LN3B };

DEV unsigned pk2(float lo, float hi) { unsigned r; asm("v_cvt_pk_bf16_f32 %0, %1, %2" : "=v"(r) : "v"(lo), "v"(hi)); return r; }
DEV float bf2f(bf16_t v) { return __uint_as_float((unsigned)v << 16); }
DEV float bflo(unsigned v) { return __uint_as_float(v << 16); }
DEV float bfhi(unsigned v) { return __uint_as_float(v & 0xffff0000u); }
DEV float fexp2(float x) { return __builtin_amdgcn_exp2f(x); }
DEV float fexp(float x) { return __builtin_amdgcn_exp2f(x * LOG2E); }
DEV float sigmoidf_(float x) { return 1.0f / (1.0f + fexp(-x)); }
DEV int tidx() { int t = __builtin_amdgcn_workitem_id_x(); asm volatile("" : "+v"(t)); return t; }
#ifndef WT_SCOPE
#define WT_SCOPE __HIP_MEMORY_SCOPE_AGENT
#endif
DEV void wt_store8(void* ptr, u32x2 v) { *(u32x2*)ptr = v; }
DEV void wt_store4f(float* ptr, float v) { *ptr = v; }
DEV void wt_store2(bf16_t* ptr, bf16_t v) { *ptr = v; }
DEV void wt_store16(void* ptr, u32x4 v) { *(u32x4*)ptr = v; }
#define MFMA(a, b, c) __builtin_amdgcn_mfma_f32_16x16x32_bf16((a), (b), (c), 0, 0, 0)

DEV u32x4 coh_load16(const bf16_t* ptr) {
    const unsigned long long* q = (const unsigned long long*)ptr;
    const unsigned long long a = __hip_atomic_load(q, __ATOMIC_RELAXED, __HIP_MEMORY_SCOPE_SYSTEM);
    const unsigned long long b = __hip_atomic_load(q + 1, __ATOMIC_RELAXED, __HIP_MEMORY_SCOPE_SYSTEM);
    u32x4 r; r.x = (unsigned)a; r.y = (unsigned)(a >> 32); r.z = (unsigned)b; r.w = (unsigned)(b >> 32); return r;
}
template <int MI, bool COH>
DEV void gemm_gload(const bf16_t* A, int lda, int m0, const bf16_t* Bt, int ldb, int n0, int k0, u32x4 (&ra)[4], u32x4 (&rb)[MI]) {
    const int T = tidx();
#pragma unroll
    for (int i = 0; i < 4; ++i) {
        const int q = i * 256 + T, r = q >> 3, lc = (q & 7) ^ (r & 7);
        if (COH) {
#ifdef DBG_XQ_F32
            { const float* Af = (const float*)A + (size_t)(m0 + r) * lda + k0 + lc * 8; const f32x4 v0 = *(const f32x4*)Af, v1 = *(const f32x4*)(Af + 4); u32x4 t; t.x = pk2(v0[0], v0[1]); t.y = pk2(v0[2], v0[3]); t.z = pk2(v1[0], v1[1]); t.w = pk2(v1[2], v1[3]); ra[i] = t; }
            if (i < MI) rb[i] = *(const u32x4*)(Bt + (size_t)(n0 + r) * ldb + k0 + lc * 8);
            continue;
#endif
            ra[i] = coh_load16(A + (size_t)(m0 + r) * lda + k0 + lc * 8);
            if (i < MI) rb[i] = coh_load16(Bt + (size_t)(n0 + r) * ldb + k0 + lc * 8);
        } else {
            ra[i] = *(const u32x4*)(A + (size_t)(m0 + r) * lda + k0 + lc * 8);
            if (i < MI) rb[i] = *(const u32x4*)(Bt + (size_t)(n0 + r) * ldb + k0 + lc * 8);
        }
    }
}
template <int MI>
DEV void gemm_sstore(lds_char* st, const u32x4 (&ra)[4], const u32x4 (&rb)[MI]) {
    const int T = tidx();
#pragma unroll
    for (int i = 0; i < 4; ++i) {
        const int q = i * 256 + T;
        *(LDS u32x4*)(st + q * 16) = ra[i];
        if (i < MI) *(LDS u32x4*)(st + 16384 + q * 16) = rb[i];
    }
}
template <int MI, bool COH = false>
DEV void gemm_acc(f32x4 (&acc)[MI][4], const bf16_t* A, int lda, int m0, const bf16_t* Bt, int ldb, int n0, int K, lds_char* smem) {
    constexpr int WN = MI / 2;
    const int T = tidx(), lane = T & 63, w = T >> 6, wr = w / WN, wc = w % WN, fr = lane & 15, fq = lane >> 4;
    const int nt = K >> 6;
    u32x4 ra[4], rb[MI];
    gemm_gload<MI, COH>(A, lda, m0, Bt, ldb, n0, 0, ra, rb);
    __syncthreads();
    for (int t = 0; t < nt; ++t) {
        lds_char* a = smem + (t & 1) * 32768;
        lds_char* b = a + 16384;
        gemm_sstore<MI>(a, ra, rb);
        __syncthreads();
        if (t + 1 < nt) gemm_gload<MI, COH>(A, lda, m0, Bt, ldb, n0, (t + 1) * 64, ra, rb);
#pragma unroll
        for (int ks = 0; ks < 2; ++ks) {
            bf16x8 af[MI], bfr[4];
#pragma unroll
            for (int m = 0; m < MI; ++m) { const int r = wr * (MI * 16) + m * 16 + fr; af[m] = *(const LDS bf16x8*)(a + r * 128 + (((ks * 4 + fq) ^ (r & 7)) << 4)); }
#pragma unroll
            for (int n = 0; n < 4; ++n) { const int r = wc * 64 + n * 16 + fr; bfr[n] = *(const LDS bf16x8*)(b + r * 128 + (((ks * 4 + fq) ^ (r & 7)) << 4)); }
#pragma unroll
            for (int m = 0; m < MI; ++m)
#pragma unroll
                for (int n = 0; n < 4; ++n) acc[m][n] = MFMA(bfr[n], af[m], acc[m][n]);
        }
    }
}
template <int MI>
DEV void zero_acc(f32x4 (&acc)[MI][4]) {
#pragma unroll
    for (int m = 0; m < MI; ++m)
#pragma unroll
        for (int n = 0; n < 4; ++n) acc[m][n] = (f32x4){0.f, 0.f, 0.f, 0.f};
}
#define GEMM_IDS_(MI) const int T = tidx(), lane = T & 63, w = T >> 6, wr = w / ((MI) / 2), wc = w % ((MI) / 2), fr = lane & 15, fq = lane >> 4; constexpr int MI_ = (MI); (void)T; (void)lane; (void)w
#define GEMM_IDS GEMM_IDS_(4)
#define CROW(m) (m0 + wr * (MI_ * 16) + (m) * 16 + fr)
#define CCOL(n) (n0 + wc * 64 + (n) * 16 + fq * 4)

template <int MI>
DEV void epi_bf16(const f32x4 (&acc)[MI][4], bf16_t* dst, int ld, int m0, int n0) {
    GEMM_IDS_(MI);
    float one = 1.0f; asm volatile("" : "+v"(one));
#pragma unroll
    for (int m = 0; m < MI; ++m)
#pragma unroll
        for (int n = 0; n < 4; ++n) {
            const f32x4 a = acc[m][n] * one;
            u32x2 v; v.x = pk2(a[0], a[1]); v.y = pk2(a[2], a[3]);
            wt_store8(dst + (size_t)CROW(m) * ld + CCOL(n), v);
        }
}
DEV void epi_res(const f32x4 (&acc)[4][4], const float* res, float* out, int m0, int n0) {
    GEMM_IDS;
#pragma unroll
    for (int m = 0; m < 4; ++m)
#pragma unroll
        for (int n = 0; n < 4; ++n) {
            const size_t o = (size_t)CROW(m) * DM + CCOL(n);
            const f32x4 r = *(const f32x4*)(res + o);
            { f32x4 a = acc[m][n];
#ifdef DBG_SANITIZE
              for (int e = 0; e < 4; ++e) if (!(fabsf(a[e]) < 1e30f)) a[e] = 0.f;
#endif
              const f32x4 y = r * ALPHA + a; wt_store16(out + o, __builtin_bit_cast(u32x4, y)); }
        }
}

DEV void transpose_tile(const float* __restrict__ src, int N, bf16_t* __restrict__ dst, int K, int k0, int n0, lds_char* smem) {
    LDS float* t = (LDS float*)smem;
    const int T = tidx();
    __syncthreads();
#pragma unroll
    for (int i = 0; i < 4; ++i) {
        const int q = i * 256 + T, r = q >> 4, c = (q & 15) * 4;
        const f32x4 v = *(const f32x4*)(src + (size_t)(k0 + r) * N + n0 + c);
        t[r * 65 + c] = v[0]; t[r * 65 + c + 1] = v[1]; t[r * 65 + c + 2] = v[2]; t[r * 65 + c + 3] = v[3];
    }
    __syncthreads();
#pragma unroll
    for (int i = 0; i < 2; ++i) {
        const int q = i * 256 + T, rr = q >> 3, cc = (q & 7) * 8;
        u32x4 v;
        v.x = pk2(t[(cc + 0) * 65 + rr], t[(cc + 1) * 65 + rr]); v.y = pk2(t[(cc + 2) * 65 + rr], t[(cc + 3) * 65 + rr]);
        v.z = pk2(t[(cc + 4) * 65 + rr], t[(cc + 5) * 65 + rr]); v.w = pk2(t[(cc + 6) * 65 + rr], t[(cc + 7) * 65 + rr]);
        wt_store16(dst + (size_t)(n0 + rr) * K + k0 + cc, v);
    }
}
DEV void phase_prep(CParams& p, lds_char* smem) {
    const int G = gridDim.x, bid = blockIdx.x, T = tidx();
    bf16_t* WT = (bf16_t*)(p.ws + OFF_WT);
    for (int u = bid; u < 2 * 5984; u += G) {
        const int l = u / 5984; int t = u % 5984;
        const float* src; size_t doff; int K, N;
        if (t < 2048) { src = p.in[I_WIN] + (size_t)l * 1024 * 8192; doff = W_IN; K = 1024; N = 8192; }
        else if ((t -= 2048) < 128) { src = p.in[I_BRA] + (size_t)l * 512 * 1024; doff = W_BRA; K = 512; N = 1024; }
        else if ((t -= 128) < 256) { src = p.in[I_BRB] + (size_t)l * 1024 * 1024; doff = W_BRB; K = 1024; N = 1024; }
        else if ((t -= 256) < 128) { src = p.in[I_BRC] + (size_t)l * 512 * 1024; doff = W_BRC; K = 512; N = 1024; }
        else if ((t -= 128) < 256) { src = p.in[I_WOUT] + (size_t)l * 1024 * 1024; doff = W_OUT; K = 1024; N = 1024; }
        else if ((t -= 256) < 256) { src = p.in[I_XQ] + (size_t)l * 1024 * 1024; doff = W_XQ; K = 1024; N = 1024; }
        else if ((t -= 256) < 512) { src = p.in[I_XKV] + (size_t)l * 1024 * 2048; doff = W_XKV; K = 1024; N = 2048; }
        else if ((t -= 512) < 256) { src = p.in[I_XO] + (size_t)l * 1024 * 1024; doff = W_XO; K = 1024; N = 1024; }
        else if ((t -= 256) < 1408) { src = p.in[I_WUP] + (size_t)l * 1024 * 5632; doff = W_UP; K = 1024; N = 5632; }
        else if ((t -= 1408) < 704) { src = p.in[I_WDOWN] + (size_t)l * 2816 * 1024; doff = W_DOWN; K = 2816; N = 1024; }
        else { t -= 704; src = p.in[I_GATEW] + (size_t)l * 131072 + (size_t)t * 4096; doff = W_GW + (size_t)t * 4096; K = 64; N = 64; t = 0; }
        const int tn = N >> 6;
        transpose_tile(src, N, WT + (size_t)l * WL_ELEMS + doff, K, (t / tn) * 64, (t % tn) * 64, smem);
    }
    {
        const f32x4* x4 = (const f32x4*)p.in[I_X]; u32x2* xb = (u32x2*)(p.ws + OFF_XB);
        for (size_t i = (size_t)bid * 256 + T; i < (size_t)NTOK * DM / 4; i += (size_t)G * 256) { const f32x4 v = x4[i]; u32x2 o; o.x = pk2(v[0], v[1]); o.y = pk2(v[2], v[3]); wt_store8(&xb[i], o); }
        const f32x4* m4 = (const f32x4*)p.in[I_MEM]; u32x2* mb = (u32x2*)(p.ws + OFF_MEMB);
        for (size_t i = (size_t)bid * 256 + T; i < (size_t)2048 * DM / 4; i += (size_t)G * 256) { const f32x4 v = m4[i]; u32x2 o; o.x = pk2(v[0], v[1]); o.y = pk2(v[2], v[3]); wt_store8(&mb[i], o); }
    }
}

DEV void rot_coef(int pos, float invf, float& c, float& s) {
    const float ang = (float)pos * invf;
    const float n = rintf(ang * 0.15915494309189535f);
    float r = fmaf(-n, 6.2831854820251465f, ang);
    r = fmaf(-n, -1.7484556025237907e-07f, r);
    c = __cosf(r); s = __sinf(r);
}
DEV void phase_u(CParams& p, int l, lds_char* smem) {
    const int G = gridDim.x, bid = blockIdx.x;
    const bf16_t* xb = (const bf16_t*)(p.ws + OFF_XB);
    const bf16_t* WT = (const bf16_t*)(p.ws + OFF_WT) + (size_t)l * WL_ELEMS;
    const int nkv = 0;
#ifdef DBG_U_XQ
    const int nu = 512 * 48 + nkv;
#else
    const int nu = 512 * 40 + nkv;
#endif
    for (int uu = bid; uu < nu; uu += G) {
        f32x4 acc[4][4]; zero_acc<4>(acc);
        if (uu < nkv) {
            const int v = uu, ll = v >> 8, t = v & 255, m0 = (t >> 4) * 128, n0 = (t & 15) * 128;
            gemm_acc<4, false>(acc, (const bf16_t*)(p.ws + OFF_MEMB), 1024, m0, (const bf16_t*)(p.ws + OFF_WT) + (size_t)ll * WL_ELEMS + W_XKV, 1024, n0, 1024, smem);
            epi_bf16<4>(acc, (bf16_t*)(p.ws + OFF_MEMKV) + (size_t)ll * 2048 * 2048, 2048, m0, n0);
            continue;
        }
        const int u = uu - nkv;
#ifdef DBG_U_XQ
        const int m0 = (u / 48) * 128, n0 = (u % 48) * 128;
        gemm_acc<4>(acc, xb, 1024, m0, (n0 < 5120) ? (WT + W_IN) : (WT + (W_XQ - (size_t)5120 * 1024)), 1024, n0, 1024, smem);
        if (n0 >= 5120) { if (m0 < 16384) epi_bf16<4>(acc, (bf16_t*)(p.ws + 984 * MiB), 1024, m0, n0 - 5120); continue; }
#else
        const int m0 = (u / 40) * 128, n0 = (u % 40) * 128;
        gemm_acc<4>(acc, xb, 1024, m0, WT + W_IN, 1024, n0, 1024, smem);
#endif
        bf16_t* dst; int ld, c0; bool rot = false;
        if (n0 < 512) { dst = (bf16_t*)(p.ws + OFF_AQ); ld = 512; c0 = n0; rot = true; }
        else if (n0 < 1024) { dst = (bf16_t*)(p.ws + OFF_AK); ld = 512; c0 = n0 - 512; rot = true; }
        else if (n0 < 1536) { dst = (bf16_t*)(p.ws + OFF_AV); ld = 512; c0 = n0 - 1024; }
        else if (n0 < 2560) { dst = (bf16_t*)(p.ws + OFF_RX); ld = 1024; c0 = n0 - 1536; }
        else if (n0 < 3584) { dst = (bf16_t*)(p.ws + OFF_RG); ld = 1024; c0 = n0 - 2560; }
        else if (n0 < 4096) { dst = (bf16_t*)(p.ws + OFF_CQ); ld = 512; c0 = n0 - 3584; rot = true; }
        else if (n0 < 4608) { dst = (bf16_t*)(p.ws + OFF_CK); ld = 512; c0 = n0 - 4096; rot = true; }
        else { dst = (bf16_t*)(p.ws + OFF_CV); ld = 512; c0 = n0 - 4608; }
        GEMM_IDS;
        if (rot) {
            const bool hi = (fq & 2) != 0, odd = (fq & 1) != 0;
            const float f0 = odd ? 0.001414213562373095f : 1.0f, f1 = odd ? 0.0002742481756762073f : 0.19392274474868576f,
                        f2 = odd ? 5.318295896944988e-05f : 0.03760603093086393f, f3 = odd ? 1.031338537721246e-05f : 0.007292664737217109f;
#pragma unroll
            for (int m = 0; m < 4; ++m) {
                const int pos = CROW(m) & (SEQ - 1);
                f32x4 v = acc[m][0], o;
#pragma unroll
                for (int j = 0; j < 4; ++j) {
                    const float pv = __shfl_xor(v[j], 32);
                    float c, s; rot_coef(pos, j == 0 ? f0 : j == 1 ? f1 : j == 2 ? f2 : f3, c, s);
                    o[j] = hi ? (v[j] * c + pv * s) : (v[j] * c - pv * s);
                }
                acc[m][0] = o;
            }
        }
        epi_bf16<4>(acc, dst, ld, m0, c0);
    }
}

template <int D, int DV, int KW, int MT, int MODE, bool PF>
DEV void flash_core(const bf16_t* __restrict__ Qp, int ldq, int qtok0, int qstride, int qrow0,
                    const bf16_t* __restrict__ Kp, int ldk, const bf16_t* __restrict__ Vp, int ldv, int ktok0, int kstride,
                    int kt_begin, int kt_end, int koff, float sc, int qpos0, lds_char* smem,
                    f32x4 (&o)[MT][DV / 16], float (&mrow)[MT], float (&lrow)[MT]) {
    const int T = tidx(), lane = T & 63, fr = lane & 15, fq = lane >> 4;
    constexpr int KSTR = KW * 2 + 16, VSTR = DV * 2 + 32;
    lds_char* Ks = smem;
    lds_char* Vs = smem + 64 * KSTR;
    constexpr int KCH = KW / 8, NKL = 64 * KCH / 256, VCH = DV / 8, NVL = 64 * VCH / 256;
    bf16x8 qf[MT][D / 32];
#pragma unroll
    for (int mt = 0; mt < MT; ++mt)
#pragma unroll
        for (int ks = 0; ks < D / 32; ++ks)
            qf[mt][ks] = *(const bf16x8*)(Qp + (size_t)(qtok0 + (qrow0 + mt * 16 + fr) * qstride) * ldq + ks * 32 + fq * 8);
#pragma unroll
    for (int mt = 0; mt < MT; ++mt) {
        mrow[mt] = -1e30f; lrow[mt] = 0.f;
#pragma unroll
        for (int dt = 0; dt < DV / 16; ++dt) o[mt][dt] = (f32x4){0.f, 0.f, 0.f, 0.f};
    }
    u32x4 kreg[NKL], vreg[NVL];
    if (PF && kt_begin < kt_end) {
#pragma unroll
        for (int i = 0; i < NKL; ++i) { const int q = i * 256 + T, row = q / KCH, ch = q % KCH; kreg[i] = *(const u32x4*)(Kp + (size_t)(ktok0 + (kt_begin * 64 + row) * kstride) * ldk + ch * 8); }
#pragma unroll
        for (int i = 0; i < NVL; ++i) { const int q = i * 256 + T, row = q / VCH, ch = q % VCH; vreg[i] = *(const u32x4*)(Vp + (size_t)(ktok0 + (kt_begin * 64 + row) * kstride) * ldv + ch * 8); }
    }
    const int vbase = (4 * fq + ((lane >> 2) & 3)) * VSTR + (lane & 3) * 8;
    for (int kt = kt_begin; kt < kt_end; ++kt) {
        if (!PF) {
#pragma unroll
            for (int i = 0; i < NKL; ++i) { const int q = i * 256 + T, row = q / KCH, ch = q % KCH; kreg[i] = *(const u32x4*)(Kp + (size_t)(ktok0 + (kt * 64 + row) * kstride) * ldk + ch * 8); }
#pragma unroll
            for (int i = 0; i < NVL; ++i) { const int q = i * 256 + T, row = q / VCH, ch = q % VCH; vreg[i] = *(const u32x4*)(Vp + (size_t)(ktok0 + (kt * 64 + row) * kstride) * ldv + ch * 8); }
        }
        __syncthreads();
#pragma unroll
        for (int i = 0; i < NKL; ++i) { const int q = i * 256 + T, row = q / KCH, ch = q % KCH; *(LDS u32x4*)(Ks + row * KSTR + ch * 16) = kreg[i]; }
#pragma unroll
        for (int i = 0; i < NVL; ++i) { const int q = i * 256 + T, row = q / VCH, ch = q % VCH; *(LDS u32x4*)(Vs + row * VSTR + ch * 16) = vreg[i]; }
        __syncthreads();
        if (PF && kt + 1 < kt_end) {
#pragma unroll
            for (int i = 0; i < NKL; ++i) { const int q = i * 256 + T, row = q / KCH, ch = q % KCH; kreg[i] = *(const u32x4*)(Kp + (size_t)(ktok0 + ((kt + 1) * 64 + row) * kstride) * ldk + ch * 8); }
#pragma unroll
            for (int i = 0; i < NVL; ++i) { const int q = i * 256 + T, row = q / VCH, ch = q % VCH; vreg[i] = *(const u32x4*)(Vp + (size_t)(ktok0 + ((kt + 1) * 64 + row) * kstride) * ldv + ch * 8); }
        }
        bool act = true;
        if (MODE == 1) act = (64 * kt + 63 >= qrow0) && (64 * kt <= qrow0 + MT * 16 - 1 + 128);
        if (act) {
            const bool domask = (MODE == 0) ? (kt == kt_end - 1) : (MODE == 1);
            bf16x8 pf[MT][2];
#pragma unroll
            for (int mt = 0; mt < MT; ++mt) {
                f32x4 s[4];
#pragma unroll
                for (int n = 0; n < 4; ++n) s[n] = (f32x4){0.f, 0.f, 0.f, 0.f};
#pragma unroll
                for (int ks = 0; ks < D / 32; ++ks) {
#pragma unroll
                    for (int n = 0; n < 4; ++n) {
                        const bf16x8 kf = *(const LDS bf16x8*)(Ks + (n * 16 + fr) * KSTR + (koff + ks * 32 + fq * 8) * 2);
                        s[n] = MFMA(kf, qf[mt][ks], s[n]);
                    }
                }
                const int qi = qrow0 + mt * 16 + fr;
                float mx = -INFINITY;
#pragma unroll
                for (int n = 0; n < 4; ++n)
#pragma unroll
                    for (int j = 0; j < 4; ++j) {
                        float v = s[n][j] * sc;
                        if (domask) {
                            const int kj = kt * 64 + n * 16 + fq * 4 + j;
                            bool ok;
                            if (MODE == 0) ok = kj <= qpos0 + qi; else ok = (kj >= qi) && (kj <= qi + 128);
                            if (!ok) v = -INFINITY;
                        }
                        s[n][j] = v; mx = fmaxf(mx, v);
                    }
                mx = fmaxf(mx, __shfl_xor(mx, 16)); mx = fmaxf(mx, __shfl_xor(mx, 32));
                const float mn = fmaxf(mrow[mt], mx);
                const float alpha = fexp2(mrow[mt] - mn);
                mrow[mt] = mn;
                float rs = 0.f;
#pragma unroll
                for (int n = 0; n < 4; ++n)
#pragma unroll
                    for (int j = 0; j < 4; ++j) { const float pe = fexp2(s[n][j] - mn); s[n][j] = pe; rs += pe; }
                lrow[mt] = lrow[mt] * alpha + rs;
#pragma unroll
                for (int dt = 0; dt < DV / 16; ++dt) o[mt][dt] *= alpha;
#pragma unroll
                for (int k2 = 0; k2 < 2; ++k2) {
                    u32x4 t;
                    t.x = pk2(s[2 * k2][0], s[2 * k2][1]); t.y = pk2(s[2 * k2][2], s[2 * k2][3]);
                    t.z = pk2(s[2 * k2 + 1][0], s[2 * k2 + 1][1]); t.w = pk2(s[2 * k2 + 1][2], s[2 * k2 + 1][3]);
                    pf[mt][k2] = __builtin_bit_cast(bf16x8, t);
                }
            }
#pragma unroll
            for (int k2 = 0; k2 < 2; ++k2)
#pragma unroll
                for (int dt = 0; dt < DV / 16; ++dt) {
                    const s16x4 v0 = __builtin_amdgcn_ds_read_tr16_b64_v4i16((LDS s16x4*)(Vs + vbase + (k2 * 32) * VSTR + dt * 32));
                    const s16x4 v1 = __builtin_amdgcn_ds_read_tr16_b64_v4i16((LDS s16x4*)(Vs + vbase + (k2 * 32 + 16) * VSTR + dt * 32));
                    const bf16x8 vf = __builtin_shufflevector(v0, v1, 0, 1, 2, 3, 4, 5, 6, 7);
#pragma unroll
                    for (int mt = 0; mt < MT; ++mt) o[mt][dt] = MFMA(vf, pf[mt][k2], o[mt][dt]);
                }
        }
    }
}

DEV void diff_unit(CParams& p, int l, int unit, lds_char* smem) {
    const int T = tidx(), lane = T & 63, w = T >> 6, fr = lane & 15, fq = lane >> 4;
    const int qt = 127 - (unit >> 5), bh = unit & 31, b = bh >> 2, h = bh & 3;
    const int comp = w >> 1, qrow0 = (w & 1) * 32;
    f32x4 o[2][8]; float mrow[2], lrow[2];
    bf16_t* aq = (bf16_t*)(p.ws + OFF_AQ);
    flash_core<64, 128, 128, 2, 0, false>(aq + h * 128 + comp * 64, 512, b * SEQ + qt * 64, 1, qrow0,
                                   (const bf16_t*)(p.ws + OFF_AK) + h * 128, 512, (const bf16_t*)(p.ws + OFF_AV) + h * 128, 512, b * SEQ, 1,
                                   0, qt + 1, comp * 64, 0.125f * LOG2E, qt * 64, smem, o, mrow, lrow);
    int l2 = l; asm volatile("" : "+s"(l2));
    const float linit = (l2 == 0) ? 0.2f : 0.35550906759096934f;
    float lam;
    {
        const float* lq = p.in[I_LAMQK] + l2 * 256;
        float s1 = lq[lane] * lq[64 + lane], s2 = lq[128 + lane] * lq[192 + lane];
#pragma unroll
        for (int o = 32; o >= 1; o >>= 1) { s1 += __shfl_xor(s1, o); s2 += __shfl_xor(s2, o); }
        lam = expf(s1) - expf(s2) + linit;
    }
#pragma unroll
    for (int mt = 0; mt < 2; ++mt) {
        float lt = lrow[mt]; lt += __shfl_xor(lt, 16); lt += __shfl_xor(lt, 32);
        const float inv = 1.0f / lt;
#pragma unroll
        for (int dt = 0; dt < 8; ++dt) o[mt][dt] *= inv;
    }
    __syncthreads();
    LDS float* X = (LDS float*)smem;
    if (comp == 1) {
#pragma unroll
        for (int mt = 0; mt < 2; ++mt)
#pragma unroll
            for (int dt = 0; dt < 8; ++dt) *(LDS f32x4*)(X + ((w & 1) * 32 + mt * 16 + fr) * 132 + dt * 16 + fq * 4) = o[mt][dt];
    }
    __syncthreads();
    if (comp == 0) {
        const float* g = p.in[I_SUBLN] + l * 128;
#pragma unroll
        for (int mt = 0; mt < 2; ++mt) {
            float ss = 0.f;
#pragma unroll
            for (int dt = 0; dt < 8; ++dt) {
                const f32x4 o2 = *(const LDS f32x4*)(X + ((w & 1) * 32 + mt * 16 + fr) * 132 + dt * 16 + fq * 4);
                o[mt][dt] = o[mt][dt] - lam * o2;
                ss += o[mt][dt][0] * o[mt][dt][0] + o[mt][dt][1] * o[mt][dt][1] + o[mt][dt][2] * o[mt][dt][2] + o[mt][dt][3] * o[mt][dt][3];
            }
            ss += __shfl_xor(ss, 16); ss += __shfl_xor(ss, 32);
            const float r = rsqrtf(ss * (1.0f / 128.0f) + 1e-5f) * (1.0f - linit);
            bf16_t* dst = aq + (size_t)(b * SEQ + qt * 64 + qrow0 + mt * 16 + fr) * 512 + h * 128 + fq * 4;
#pragma unroll
            for (int dt = 0; dt < 8; ++dt) {
                const f32x4 gg = *(const f32x4*)(g + dt * 16 + fq * 4);
                u32x2 v; v.x = pk2(o[mt][dt][0] * r * gg[0], o[mt][dt][1] * r * gg[1]); v.y = pk2(o[mt][dt][2] * r * gg[2], o[mt][dt][3] * r * gg[3]);
                wt_store8(dst + dt * 16, v);
            }
        }
    }
}

DEV void dil_unit(CParams& p, int pat, int unit, lds_char* smem) {
    const int T = tidx(), lane = T & 63, w = T >> 6, fr = lane & 15, fq = lane >> 4;
    const int dil = (pat == 0) ? 1 : (pat == 1) ? 4 : 16;
    const int bh = unit & 63, b = bh >> 3, head = bh & 7, pn = unit >> 6, ph = pn % dil, n = pn / dil;
    const int qrow0 = w * 32;
    f32x4 o[2][4]; float mrow[2], lrow[2];
    const int qtok0 = b * SEQ + n * 128 * dil + ph, ktok0 = b * SEQ + (n - 1) * 128 * dil + ph;
    flash_core<64, 64, 64, 2, 1, true>((const bf16_t*)(p.ws + OFF_CQ) + head * 64, 512, qtok0, dil, qrow0,
                                 (const bf16_t*)(p.ws + OFF_CK) + head * 64, 512, (const bf16_t*)(p.ws + OFF_CV) + head * 64, 512, ktok0, dil,
                                 (n == 0) ? 2 : 0, 4, 0, 0.125f * LOG2E, 0, smem, o, mrow, lrow);
    bf16_t* oc = (bf16_t*)(p.ws + OFF_OC);
    float* lsebuf = (float*)(p.ws + OFF_LSE);
#pragma unroll
    for (int mt = 0; mt < 2; ++mt) {
        float lt = lrow[mt]; lt += __shfl_xor(lt, 16); lt += __shfl_xor(lt, 32);
        const float inv = 1.0f / lt;
        float lse = (mrow[mt] + log2f(lt)) * LN2;
        const size_t tok = (size_t)qtok0 + (size_t)(qrow0 + mt * 16 + fr) * dil;
        bf16_t* dst = oc + tok * 512 + head * 64 + fq * 4;
        float wn = inv, wo = 0.f;
        if (pat > 0) {
            const float lo = lsebuf[tok * 8 + head];
            const float mxl = fmaxf(lo, lse);
            const float eo = fexp(lo - mxl), en = fexp(lse - mxl);
            const float tot = eo + en;
            wo = eo / tot; wn = inv * en / tot;
            lse = mxl + logf(tot);
        }
#pragma unroll
        for (int dt = 0; dt < 4; ++dt) {
            f32x4 v = o[mt][dt] * wn;
            if (pat > 0) { const u32x2 old = *(const u32x2*)(dst + dt * 16); v[0] += wo * bflo(old.x); v[1] += wo * bfhi(old.x); v[2] += wo * bflo(old.y); v[3] += wo * bfhi(old.y); }
            u32x2 r; r.x = pk2(v[0], v[1]); r.y = pk2(v[2], v[3]);
            wt_store8(dst + dt * 16, r);
        }
        if (pat < 2 && fq == 0) wt_store4f(&lsebuf[tok * 8 + head], lse);
    }
}

DEV void xattn_unit(CParams& p, int l, int unit, lds_char* smem) {
    const int T = tidx(), lane = T & 63, w = T >> 6, fr = lane & 15, fq = lane >> 4;
    const int h = unit & 3, tok0 = (unit >> 2) * 64, b = tok0 / SEQ;
    f32x4 o[1][16]; float mrow[1], lrow[1];
    bf16_t* qx = (bf16_t*)(p.ws + OFF_QX);
    const bf16_t* kv = (const bf16_t*)(p.ws + OFF_MEMKV) + (size_t)l * 2048 * 2048;
    flash_core<256, 256, 256, 1, 2, false>(qx + h * 256, 1024, tok0, 1, w * 16, kv + h * 256, 2048, kv + 1024 + h * 256, 2048, b * 256, 1,
                                    0, 4, 0, 0.0625f * LOG2E, 0, smem, o, mrow, lrow);
    float lt = lrow[0]; lt += __shfl_xor(lt, 16); lt += __shfl_xor(lt, 32);
    const float inv = 1.0f / lt;
    bf16_t* dst = qx + (size_t)(tok0 + w * 16 + fr) * 1024 + h * 256 + fq * 4;
#pragma unroll
    for (int dt = 0; dt < 16; ++dt) {
        u32x2 r; r.x = pk2(o[0][dt][0] * inv, o[0][dt][1] * inv); r.y = pk2(o[0][dt][2] * inv, o[0][dt][3] * inv);
        wt_store8(dst + dt * 16, r);
    }
}

DEV float neg_expm1(float x) {
    if (x > -0.3f) { float r = 1.0f / 720.0f; r = r * x + 1.0f / 120.0f; r = r * x + 1.0f / 24.0f; r = r * x + 1.0f / 6.0f; r = r * x + 0.5f; r = r * x + 1.0f; return -(r * x); }
    return 1.0f - fexp(x);
}
DEV float gelu_tanh(float x) {
    const float y = 0.7978845608028654f * (x + 0.044715f * x * x * x);
    const float t = 1.0f - 2.0f / (fexp(2.0f * y) + 1.0f);
    return 0.5f * x * (1.0f + t);
}
DEV void lru_unit(CParams& p, int l, int unit, int pass, lds_char* smem) {
    const int T = tidx(), lane = T & 63, w = T >> 6, fr = lane & 15, fq = lane >> 4;
    const int grp = unit & 3, c = (unit >> 2) & 127, b = unit >> 9;
    const int nb = grp * 4 + w, ch0 = nb * 64;
    lds_char* Xs = smem + w * 19456;
    lds_char* XCs = Xs + 9728;
    const bf16_t* rx = (const bf16_t*)(p.ws + OFF_RX);
    bf16_t* rg = (bf16_t*)(p.ws + OFF_RG);
    __syncthreads();
    for (int q = lane; q < 536; q += 64) {
        const int r = q >> 3, ch = q & 7, s = c * 64 + r - 3;
        u32x4 v = (u32x4){0u, 0u, 0u, 0u};
        if (s >= 0) v = *(const u32x4*)(rx + ((size_t)b * SEQ + s) * 1024 + ch0 + ch * 8);
        *(LDS u32x4*)(Xs + r * 144 + ch * 16) = v;
    }
    __syncthreads();
    {
        const int ch = lane & 7;
        const float* cw = p.in[I_CONVW] + (size_t)l * 4096 + ch0 + ch * 8;
        const float* cb = p.in[I_CONVB] + (size_t)l * 1024 + ch0 + ch * 8;
        float wv[4][8], bv[8];
#pragma unroll
        for (int e = 0; e < 8; ++e) { bv[e] = cb[e];
#pragma unroll
            for (int tp = 0; tp < 4; ++tp) wv[tp][e] = cw[tp * 1024 + e]; }
#pragma unroll
        for (int it = 0; it < 8; ++it) {
            const int t = it * 8 + (lane >> 3);
            float a[8];
#pragma unroll
            for (int e = 0; e < 8; ++e) a[e] = bv[e];
#pragma unroll
            for (int tp = 0; tp < 4; ++tp) {
                const u32x4 xv = *(const LDS u32x4*)(Xs + (t + tp) * 144 + ch * 16);
                a[0] += bflo(xv.x) * wv[tp][0]; a[1] += bfhi(xv.x) * wv[tp][1]; a[2] += bflo(xv.y) * wv[tp][2]; a[3] += bfhi(xv.y) * wv[tp][3];
                a[4] += bflo(xv.z) * wv[tp][4]; a[5] += bfhi(xv.z) * wv[tp][5]; a[6] += bflo(xv.w) * wv[tp][6]; a[7] += bfhi(xv.w) * wv[tp][7];
            }
            u32x4 ov; ov.x = pk2(a[0], a[1]); ov.y = pk2(a[2], a[3]); ov.z = pk2(a[4], a[5]); ov.w = pk2(a[6], a[7]);
            *(LDS u32x4*)(XCs + t * 144 + ch * 16) = ov;
        }
    }
    __syncthreads();
    const bf16_t* gw = (const bf16_t*)(p.ws + OFF_WT) + (size_t)l * WL_ELEMS + W_GW;
    bf16x8 gf[2][4][2];
#pragma unroll
    for (int g = 0; g < 2; ++g)
#pragma unroll
        for (int nt = 0; nt < 4; ++nt)
#pragma unroll
            for (int ks = 0; ks < 2; ++ks) gf[g][nt][ks] = *(const bf16x8*)(gw + ((size_t)(g * 16 + nb) * 64 + nt * 16 + fr) * 64 + ks * 32 + fq * 8);
    float sp[4], gb0[4], gb1[4], hin[4], atot[4];
#pragma unroll
    for (int nt = 0; nt < 4; ++nt) {
        const int ch = ch0 + nt * 16 + fr;
        const float lam = p.in[I_LAMBDA][l * 1024 + ch];
        const float x = fexp(-lam);
        sp[nt] = (x < 0.03f) ? x * (1.0f + x * (-0.5f + x * (1.0f / 3.0f + x * (-0.25f + x * 0.2f)))) : logf(1.0f + x);
        gb0[nt] = p.in[I_GATEB][l * 2048 + ch]; gb1[nt] = p.in[I_GATEB][l * 2048 + 1024 + ch];
        atot[nt] = 1.0f;
        hin[nt] = (pass == 1) ? ((const float*)(p.ws + OFF_LH))[((size_t)b * 128 + c) * 1024 + ch] : 0.0f;
    }
    for (int m = 0; m < 4; ++m) {
        f32x4 ar[4], ai[4];
#pragma unroll
        for (int nt = 0; nt < 4; ++nt) { ar[nt] = (f32x4){0.f, 0.f, 0.f, 0.f}; ai[nt] = (f32x4){0.f, 0.f, 0.f, 0.f}; }
#pragma unroll
        for (int ks = 0; ks < 2; ++ks) {
            const bf16x8 xa = *(const LDS bf16x8*)(XCs + (m * 16 + fr) * 144 + (ks * 32 + fq * 8) * 2);
#pragma unroll
            for (int nt = 0; nt < 4; ++nt) { ar[nt] = MFMA(xa, gf[0][nt][ks], ar[nt]); ai[nt] = MFMA(xa, gf[1][nt][ks], ai[nt]); }
        }
#pragma unroll
        for (int nt = 0; nt < 4; ++nt) {
            float Pj[4], Hj[4]; float P = 1.0f, Hh = 0.0f;
#pragma unroll
            for (int j = 0; j < 4; ++j) {
                const int tk = m * 16 + fq * 4 + j;
                const float xc = bf2f(*(const LDS bf16_t*)(XCs + tk * 144 + (nt * 16 + fr) * 2));
                const float r = sigmoidf_(ar[nt][j] + gb0[nt]), ig = sigmoidf_(ai[nt][j] + gb1[nt]);
                const float la = -8.0f * r * sp[nt];
                const float a = fexp(la);
                const float u = sqrtf(neg_expm1(2.0f * la)) * (ig * xc);
                Hh = a * Hh + u; P *= a; Pj[j] = P; Hj[j] = Hh;
            }
            float A1 = P, H1 = Hh;
            { const float ta = __shfl_up(A1, 16), th = __shfl_up(H1, 16); if (fq >= 1) { H1 = A1 * th + H1; A1 = A1 * ta; } }
            { const float ta = __shfl_up(A1, 32), th = __shfl_up(H1, 32); if (fq >= 2) { H1 = A1 * th + H1; A1 = A1 * ta; } }
            float Ea = __shfl_up(A1, 16), Eh = __shfl_up(H1, 16);
            if (fq == 0) { Ea = 1.0f; Eh = 0.0f; }
            const float Ta = __shfl(A1, 48 + fr), Th = __shfl(H1, 48 + fr);
            if (pass == 1) {
                const float h0 = Ea * hin[nt] + Eh;
#pragma unroll
                for (int j = 0; j < 4; ++j) {
                    const int tk = m * 16 + fq * 4 + j;
                    const float hv = Pj[j] * h0 + Hj[j];
                    bf16_t* gp = rg + ((size_t)b * SEQ + c * 64 + tk) * 1024 + ch0 + nt * 16 + fr;
                    const float gv = bf2f(*gp);
                    wt_store2(gp, (bf16_t)(pk2(hv * gelu_tanh(gv), 0.f) & 0xffffu));
                }
            }
            hin[nt] = Ta * hin[nt] + Th; atot[nt] *= Ta;
        }
    }
    if (pass == 0 && fq == 0) {
#pragma unroll
        for (int nt = 0; nt < 4; ++nt) {
            const size_t o = ((size_t)b * 128 + c) * 1024 + ch0 + nt * 16 + fr;
            wt_store4f((float*)(p.ws + OFF_LA) + o, atot[nt]); wt_store4f((float*)(p.ws + OFF_LH) + o, hin[nt]);
        }
    }
}
DEV void lru_carry(CParams& p) {
    float* LA = (float*)(p.ws + OFF_LA); float* LH = (float*)(p.ws + OFF_LH);
    for (int i = blockIdx.x * 256 + tidx(); i < NB * 1024; i += gridDim.x * 256) {
        const int b = i >> 10, ch = i & 1023;
        float carry = 0.f;
        for (int c = 0; c < 128; ++c) {
            const size_t o = ((size_t)b * 128 + c) * 1024 + ch;
            const float a = LA[o], h = LH[o];
            wt_store4f(&LH[o], carry); carry = a * carry + h;
        }
    }
}

DEV void phase_mix(CParams& p, int l, int which, lds_char* smem) {
    const int G = gridDim.x, bid = blockIdx.x;
    if (which == 0) {
        for (int u = bid; u < 4096; u += G) diff_unit(p, l, u, smem);
        for (int u = bid; u < 4096; u += G) dil_unit(p, 0, u, smem);
        for (int u = bid; u < 4096; u += G) lru_unit(p, l, u, 0, smem);
    } else if (which == 1) {
        lru_carry(p);
        for (int u = bid; u < 4096; u += G) dil_unit(p, 1, u, smem);
    } else {
        for (int u = bid; u < 4096; u += G) dil_unit(p, 2, u, smem);
#ifndef DBG_NO_LRU1
        for (int u = bid; u < 4096; u += G) lru_unit(p, l, u, 1, smem);
#endif
    }
}

DEV void phase_merge(CParams& p, int l, lds_char* smem) {
    const int G = gridDim.x, bid = blockIdx.x;
    const bf16_t* xb = (const bf16_t*)(p.ws + OFF_XB);
    const bf16_t* WT = (const bf16_t*)(p.ws + OFF_WT) + (size_t)l * WL_ELEMS;
    for (int u = bid; u < 512 * 8; u += G) {
        const int m0 = (u >> 3) * 128, n0 = (u & 7) * 128;
        f32x4 accM[4][4]; zero_acc<4>(accM);
#pragma unroll 1
        for (int i = 0; i < 3; ++i) {
            f32x4 acc[4][4]; zero_acc<4>(acc);
            gemm_acc<4>(acc, xb, 1024, m0, WT + W_IN + (size_t)(5120 + i * 1024) * 1024, 1024, n0, 1024, smem);
            unsigned gp[4][4][2];
#pragma unroll
            for (int m = 0; m < 4; ++m)
#pragma unroll
                for (int n = 0; n < 4; ++n) { gp[m][n][0] = pk2(sigmoidf_(acc[m][n][0]), sigmoidf_(acc[m][n][1])); gp[m][n][1] = pk2(sigmoidf_(acc[m][n][2]), sigmoidf_(acc[m][n][3])); }
            zero_acc<4>(acc);
            const bf16_t* A = (i == 0) ? (const bf16_t*)(p.ws + OFF_AQ) : (i == 1) ? (const bf16_t*)(p.ws + OFF_RG) : (const bf16_t*)(p.ws + OFF_OC);
            const int Ki = (i == 1) ? 1024 : 512;
            const bf16_t* Bt = WT + ((i == 0) ? W_BRA : (i == 1) ? W_BRB : W_BRC);
            gemm_acc<4>(acc, A, Ki, m0, Bt, Ki, n0, Ki, smem);
#pragma unroll
            for (int m = 0; m < 4; ++m)
#pragma unroll
                for (int n = 0; n < 4; ++n) {
                    accM[m][n][0] += bflo(gp[m][n][0]) * acc[m][n][0]; accM[m][n][1] += bfhi(gp[m][n][0]) * acc[m][n][1];
                    accM[m][n][2] += bflo(gp[m][n][1]) * acc[m][n][2]; accM[m][n][3] += bfhi(gp[m][n][1]) * acc[m][n][3];
                }
        }
        epi_bf16<4>(accM, (bf16_t*)(p.ws + OFF_MERGED), 1024, m0, n0);
    }
}
DEV void phase_gemm_res(CParams& p, const bf16_t* A, int K, const bf16_t* Bt, const float* res, lds_char* smem) {
    const int G = gridDim.x, bid = blockIdx.x;
    for (int u = bid; u < 512 * 8; u += G) {
        const int m0 = (u >> 3) * 128, n0 = (u & 7) * 128;
        f32x4 acc[4][4]; zero_acc<4>(acc);
        gemm_acc<4>(acc, A, K, m0, Bt, K, n0, K, smem);
        epi_res(acc, res, p.out, m0, n0);
    }
}
#ifndef XQ_COH
#define XQ_COH false
#endif
DEV void phase_xq(CParams& p, int l, lds_char* smem) {
    const int G = gridDim.x, bid = blockIdx.x;
    const bf16_t* WT = (const bf16_t*)(p.ws + OFF_WT) + (size_t)l * WL_ELEMS;
#ifdef DBG_XQ_DELAY
    { const unsigned long long t0 = __builtin_amdgcn_s_memrealtime(); while (__builtin_amdgcn_s_memrealtime() - t0 < 50000ull) __builtin_amdgcn_s_sleep(8); }
#endif
#ifdef DBG_XQ_A_MERGED
    const bf16_t* xb = (const bf16_t*)(p.ws + OFF_MERGED);
#elif defined(DBG_XB2)
    const bf16_t* xb = (const bf16_t*)(p.ws + 984 * MiB);
#elif defined(DBG_XQ_F32)
    const bf16_t* xb = (const bf16_t*)p.out;
#else
    const bf16_t* xb = (const bf16_t*)(p.ws + OFF_XB);
#endif
#ifndef DBG_XQW
#define DBG_XQW W_XQ
#endif
    const bf16_t* Wq = WT + DBG_XQW;
#ifdef DBG_XB2
    bf16_t* qx = (bf16_t*)(p.ws + OFF_QX);
    for (int u = bid; u < 128 * 8; u += G) {
#elif defined(DBG_QX_ALT)
    bf16_t* qx = (bf16_t*)(p.ws + 984 * MiB);
    for (int u = bid; u < 128 * 8; u += G) {
#else
    bf16_t* qx = (bf16_t*)(p.ws + OFF_QX);
    for (int u = bid; u < 512 * 8; u += G) {
#endif
#ifdef DBG_XQ_MAP2
        const int m0 = (u & 511) * 128, n0 = (u >> 9) * 128;
#else
        const int m0 = (u >> 3) * 128, n0 = (u & 7) * 128;
#endif
        f32x4 acc[4][4]; zero_acc<4>(acc);
        gemm_acc<4, XQ_COH>(acc, xb, 1024, m0, Wq, 1024, n0, 1024, smem);
        epi_bf16<4>(acc, qx, 1024, m0, n0);
    }
}
DEV void phase_memkv(CParams& p, int l, lds_char* smem) {
    const int G = gridDim.x, bid = blockIdx.x;
    const bf16_t* WT = (const bf16_t*)(p.ws + OFF_WT) + (size_t)l * WL_ELEMS;
    for (int t = bid; t < 256; t += G) {
        f32x4 acc[4][4]; zero_acc<4>(acc);
        const int m0 = (t >> 4) * 128, n0 = (t & 15) * 128;
        gemm_acc<4>(acc, (const bf16_t*)(p.ws + OFF_MEMB), 1024, m0, WT + W_XKV, 1024, n0, 1024, smem);
        epi_bf16<4>(acc, (bf16_t*)(p.ws + OFF_MEMKV) + (size_t)l * 2048 * 2048, 2048, m0, n0);
    }
}
DEV void phase_up(CParams& p, int l, lds_char* smem) {
    const int G = gridDim.x, bid = blockIdx.x;
    const bf16_t* WT = (const bf16_t*)(p.ws + OFF_WT) + (size_t)l * WL_ELEMS;
    const bf16_t* xb = (const bf16_t*)(p.ws + OFF_XB);
    for (int u = bid; u < 512 * 22; u += G) {
        const int m0 = (u / 22) * 128, n0 = (u % 22) * 128;
        f32x4 acc[4][4]; zero_acc<4>(acc);
        gemm_acc<4>(acc, xb, 1024, m0, WT + W_UP, 1024, n0, 1024, smem);
        unsigned gp[4][4][2];
#pragma unroll
        for (int m = 0; m < 4; ++m)
#pragma unroll
            for (int n = 0; n < 4; ++n) {
                f32x4 g = acc[m][n];
#pragma unroll
                for (int j = 0; j < 4; ++j) g[j] = g[j] * sigmoidf_(g[j]);
                gp[m][n][0] = pk2(g[0], g[1]); gp[m][n][1] = pk2(g[2], g[3]);
            }
        zero_acc<4>(acc);
        gemm_acc<4>(acc, xb, 1024, m0, WT + W_UP + (size_t)2816 * 1024, 1024, n0, 1024, smem);
#pragma unroll
        for (int m = 0; m < 4; ++m)
#pragma unroll
            for (int n = 0; n < 4; ++n) {
                acc[m][n][0] *= bflo(gp[m][n][0]); acc[m][n][1] *= bfhi(gp[m][n][0]); acc[m][n][2] *= bflo(gp[m][n][1]); acc[m][n][3] *= bfhi(gp[m][n][1]);
            }
        epi_bf16<4>(acc, (bf16_t*)(p.ws + OFF_HMID), 2816, m0, n0);
    }
}

DEV void phase_ln(CParams& p, const float* g, const float* bta) {
    const int lane = tidx() & 63, w = tidx() >> 6;
    f32x4 gv[4], bv[4];
#pragma unroll
    for (int i = 0; i < 4; ++i) { gv[i] = *(const f32x4*)(g + i * 256 + lane * 4); bv[i] = *(const f32x4*)(bta + i * 256 + lane * 4); }
    for (int row = blockIdx.x * 4 + w; row < NTOK; row += gridDim.x * 4) {
        float* xr = p.out + (size_t)row * DM;
        f32x4 v[4]; float s = 0.f;
#pragma unroll
        for (int i = 0; i < 4; ++i) { v[i] = *(const f32x4*)(xr + i * 256 + lane * 4); s += v[i][0] + v[i][1] + v[i][2] + v[i][3]; }
#pragma unroll
        for (int o = 32; o >= 1; o >>= 1) s += __shfl_xor(s, o);
        const float mean = s * (1.0f / 1024.0f);
        float q = 0.f;
#pragma unroll
        for (int i = 0; i < 4; ++i) { v[i] = v[i] - mean; q += v[i][0] * v[i][0] + v[i][1] * v[i][1] + v[i][2] * v[i][2] + v[i][3] * v[i][3]; }
#pragma unroll
        for (int o = 32; o >= 1; o >>= 1) q += __shfl_xor(q, o);
        const float rstd = rsqrtf(q * (1.0f / 1024.0f) + 1e-5f);
        bf16_t* xbr = (bf16_t*)(p.ws + OFF_XB) + (size_t)row * DM;
#pragma unroll
        for (int i = 0; i < 4; ++i) {
            f32x4 y = v[i] * rstd * gv[i] + bv[i];
#ifdef DBG_SANITIZE
            for (int e = 0; e < 4; ++e) if (!(fabsf(y[e]) < 1e30f)) y[e] = 0.f;
#endif
            wt_store16(xr + i * 256 + lane * 4, __builtin_bit_cast(u32x4, y));
            u32x2 r; r.x = pk2(y[0], y[1]); r.y = pk2(y[2], y[3]);
            wt_store8(xbr + i * 256 + lane * 4, r);
#ifdef DBG_XB2
            if (row < 16384) wt_store8((bf16_t*)(p.ws + 984 * MiB) + (size_t)row * DM + i * 256 + lane * 4, r);
#endif
        }
    }
}

#ifdef DBG_PH_HI
#define EN(k) ((k) < DBG_PH_HI - 1)
#else
#define EN(k) 1
#endif
constexpr int PH_PER_LAYER = 14, N_PHASES = 1 + 2 * PH_PER_LAYER;
DEV void run_phase(CParams& p, int ph, lds_char* smem) {
    if (ph == 0) { phase_prep(p, smem); return; }
    const int l = (ph - 1) / PH_PER_LAYER, k = (ph - 1) % PH_PER_LAYER;
    const bf16_t* WT = (const bf16_t*)(p.ws + OFF_WT) + (size_t)l * WL_ELEMS;
    switch (k) {
        case 0:
#if EN(0)
            phase_u(p, l, smem);
#ifdef DBG_XQ_IN_P1
            phase_xq(p, l, smem);
#endif
#endif
            break;
        case 1:
#if EN(1)
            phase_mix(p, l, 0, smem);
#endif
            break;
        case 2:
#if EN(2)
            phase_mix(p, l, 1, smem);
#endif
            break;
        case 3:
#if EN(3)
            phase_mix(p, l, 2, smem);
#endif
            break;
        case 4:
#if EN(4)
            phase_merge(p, l, smem);
#endif
            break;
        case 5:
#if EN(5)
            phase_gemm_res(p, (const bf16_t*)(p.ws + OFF_MERGED), 1024, WT + W_OUT, (l == 0) ? p.in[I_X] : p.out, smem);
#endif
            break;
        case 6:
#if EN(6) && !defined(DBG_SKIP_LN1)
            phase_ln(p, p.in[I_LN1G] + l * 1024, p.in[I_LN1B] + l * 1024);
#endif
            break;
        case 7:
#if EN(7)
            phase_xq(p, l, smem);
            phase_memkv(p, l, smem);
#endif
            break;
        case 8:
#if EN(8)
            for (int u = blockIdx.x; u < 4096; u += gridDim.x) xattn_unit(p, l, u, smem);
#endif
            break;
        case 9:
#if EN(9)
            phase_gemm_res(p, (const bf16_t*)(p.ws + OFF_QX), 1024, WT + W_XO, p.out, smem);
#endif
            break;
        case 10:
#if EN(10)
            phase_ln(p, p.in[I_LN2G] + l * 1024, p.in[I_LN2B] + l * 1024);
#endif
            break;
        case 11:
#if EN(11)
            phase_up(p, l, smem);
#endif
            break;
        case 12:
#if EN(12)
            phase_gemm_res(p, (const bf16_t*)(p.ws + OFF_HMID), 2816, WT + W_DOWN, p.out, smem);
#endif
            break;
        default:
#if EN(13)
            phase_ln(p, p.in[I_LN3G] + l * 1024, p.in[I_LN3B] + l * 1024);
#endif
            break;
    }
}

template <int K>
__global__ void __launch_bounds__(256, 2) phase_kernel(Params p, int l) {
    extern __shared__ __attribute__((aligned(16))) char smem_raw[];
    lds_char* smem = (lds_char*)smem_raw;
    CParams* kp = (CParams*)__builtin_amdgcn_kernarg_segment_ptr();
    CParams& q = *kp;
    const bf16_t* WT = (const bf16_t*)(q.ws + OFF_WT) + (size_t)l * WL_ELEMS;
    if (K == 99) phase_prep(q, smem);
    else if (K == 0) phase_u(q, l, smem);
    else if (K == 1) phase_mix(q, l, 0, smem);
    else if (K == 2) phase_mix(q, l, 1, smem);
    else if (K == 3) phase_mix(q, l, 2, smem);
    else if (K == 4) phase_merge(q, l, smem);
    else if (K == 5) phase_gemm_res(q, (const bf16_t*)(q.ws + OFF_MERGED), 1024, WT + W_OUT, (l == 0) ? q.in[I_X] : q.out, smem);
    else if (K == 6) phase_ln(q, q.in[I_LN1G] + l * 1024, q.in[I_LN1B] + l * 1024);
    else if (K == 7) phase_xq(q, l, smem);
    else if (K == 14) phase_memkv(q, l, smem);
    else if (K == 8) { for (int u = blockIdx.x; u < 4096; u += gridDim.x) xattn_unit(q, l, u, smem); }
    else if (K == 9) phase_gemm_res(q, (const bf16_t*)(q.ws + OFF_QX), 1024, WT + W_XO, q.out, smem);
    else if (K == 10) phase_ln(q, q.in[I_LN2G] + l * 1024, q.in[I_LN2B] + l * 1024);
    else if (K == 11) phase_up(q, l, smem);
    else if (K == 12) phase_gemm_res(q, (const bf16_t*)(q.ws + OFF_HMID), 2816, WT + W_DOWN, q.out, smem);
    else phase_ln(q, q.in[I_LN3G] + l * 1024, q.in[I_LN3B] + l * 1024);
}
#ifdef DBG_SPLIT_STOP
__global__ void __launch_bounds__(256, 2) dump_kernel(Params p) {
    const size_t NW = DBG_NW;
    for (size_t i = (size_t)blockIdx.x * 256 + threadIdx.x; i < 3 * NW; i += (size_t)gridDim.x * 256) {
        const size_t r = i / NW, j = i % NW;
        const size_t off = (r == 0) ? (size_t)DBG_DUMP_OFF : (r == 1) ? (size_t)DBG_DUMP_OFF2 : (size_t)DBG_DUMP_OFF3;
#ifdef DBG_DUMP_F32
        float a0 = p.out[2 * i], a1 = p.out[2 * i + 1];
#else
        const unsigned v = ((const unsigned*)(p.ws + off))[j]; float a0 = bflo(v), a1 = bfhi(v);
#endif
        const float mk = (r == 0) ? 1.0e3f : (r == 1) ? 1.0e5f : 1.0e7f;
        if (!(fabsf(a0) < 1e30f)) a0 = mk; if (!(fabsf(a1) < 1e30f)) a1 = mk;
        p.out[2 * i] = a0; p.out[2 * i + 1] = a1;
    }
}
#endif
template <int K>
static void launch_phase(const Params& p, int l, int grid, hipStream_t stream) {
    hipFuncSetAttribute((const void*)phase_kernel<K>, hipFuncAttributeMaxDynamicSharedMemorySize, SMEM_BYTES);
    hipLaunchKernelGGL(phase_kernel<K>, dim3(grid), dim3(256), SMEM_BYTES, stream, p, l);
}
__global__ void __launch_bounds__(256, 2) mega(Params p) {
    extern __shared__ __attribute__((aligned(16))) char smem_raw[];
    lds_char* smem = (lds_char*)smem_raw;
    cg::grid_group grid = cg::this_grid();
    const int ph_lo = p.ph_lo, ph_hi = p.ph_hi;
    unsigned nbar = 0;
    if (ph_lo < 0) grid.sync();
    for (int ph = ph_lo; ph < ph_hi; ++ph) {
        CParams* kp = (CParams*)__builtin_amdgcn_kernarg_segment_ptr();
        asm volatile("" : "+s"(kp));
#ifdef DBG_SELFCHECK
        if (ph == DBG_PH_HI + 1) {
            if (blockIdx.x == 0 && tidx() == 0) {
                const unsigned c = __hip_atomic_load((unsigned*)(kp->ws + 64), __ATOMIC_RELAXED, __HIP_MEMORY_SCOPE_AGENT);
                const float b = (float)((c + 16384u) / 32768u);
                kp->out[0] = 1.0e6f * b + 7.0e5f * (float)(c < 1000000u ? c : 999999u) / 1.0e6f * 0.f;
            }
        } else
#endif
#if defined(DBG_DUMP_OFF) && defined(DBG_PH_HI)
        if (ph == DBG_PH_HI) {
#ifndef DBG_NW
#define DBG_NW 10485760
#endif
#ifndef DBG_COLEXPR
#define DBG_COLEXPR (((int)(i & 15) * 61 + (int)(row & 63)) % DBG_NCOL)
#endif
#ifdef DBG_SELFCHECK
            {
                const bf16_t* Ap = (const bf16_t*)(kp->ws + DBG_A_OFF);
                const bf16_t* Wp = (const bf16_t*)(kp->ws + OFF_WT) + DBG_W_OFF;
                const bf16_t* Cp = (const bf16_t*)(kp->ws + DBG_C_OFF);
                for (size_t i = (size_t)blockIdx.x * 256 + tidx(); i < (size_t)DBG_ROWS * 16; i += (size_t)gridDim.x * 256) {
                    const size_t row = i >> 4; const int col = DBG_COLEXPR;
                    float acc = 0.f;
                    for (int k = 0; k < 1024; ++k) {
#ifdef DBG_A_FROM_X
                        const float av = bflo(pk2(kp->in[I_X][row * 1024 + k], 0.f));
#elif defined(DBG_A_FROM_OUT)
                        const float av = bflo(pk2(kp->out[row * 1024 + k], 0.f));
#else
                        const float av = bf2f(Ap[row * 1024 + k]);
#endif
                        acc += av * bf2f(Wp[(size_t)col * 1024 + k]); }
                    const float st = bf2f(Cp[row * DBG_LDC + col]);
                    if (!(fabsf(acc - st) <= 0.02f + 0.02f * fabsf(acc))) atomicAdd((unsigned*)(kp->ws + 64), 1u);
                }
            }
#else
            const size_t NW = DBG_NW;
            for (size_t i = (size_t)blockIdx.x * 256 + tidx(); i < 3 * NW; i += (size_t)gridDim.x * 256) {
                const size_t r = i / NW, j = i % NW;
                const size_t off = (r == 0) ? (size_t)DBG_DUMP_OFF : (r == 1) ? (size_t)DBG_DUMP_OFF2 : (size_t)DBG_DUMP_OFF3;
                const unsigned v = ((const unsigned*)(kp->ws + off))[j]; { float a0 = bflo(v), a1 = bfhi(v); if (!(fabsf(a0) < 1e30f)) a0 = 12345.0f; if (!(fabsf(a1) < 1e30f)) a1 = 12345.0f; kp->out[2 * i] = a0; kp->out[2 * i + 1] = a1; }
            }
#endif
        } else
#endif
        run_phase(*kp, ph, smem);
        if (ph + 1 < ph_hi) {
#ifdef DBG_SKEW
            if ((blockIdx.x & 15) == 3) { const unsigned long long t0 = __builtin_amdgcn_s_memrealtime(); while (__builtin_amdgcn_s_memrealtime() - t0 < 30000ull) __builtin_amdgcn_s_sleep(8); }
#endif
            asm volatile("s_waitcnt vmcnt(0)" ::: "memory");
            __syncthreads();
            ++nbar;
            if (tidx() == 0) {
                __builtin_amdgcn_fence(__ATOMIC_RELEASE, "agent");
                asm volatile("s_waitcnt vmcnt(0)" ::: "memory");
                unsigned* ctr = (unsigned*)kp->ws;
                __hip_atomic_fetch_add(ctr, 1u, __ATOMIC_RELAXED, __HIP_MEMORY_SCOPE_AGENT);
                const unsigned target = nbar * gridDim.x;
                while (__hip_atomic_load(ctr, __ATOMIC_RELAXED, __HIP_MEMORY_SCOPE_AGENT) < target) __builtin_amdgcn_s_sleep(2);
            }
            __syncthreads();
            __builtin_amdgcn_fence(__ATOMIC_ACQUIRE, "agent");
        }
    }
}

extern "C" void kernel_launch(void* const* d_in, const int* in_sizes, int n_in, void* d_out, int out_size, void* d_ws, size_t ws_size, hipStream_t stream) {
    static int grid_blocks = 0;
    hipFuncSetAttribute((const void*)mega, hipFuncAttributeMaxDynamicSharedMemorySize, SMEM_BYTES);
    if (!grid_blocks) {
        int dev = 0, cus = 0, per_cu = 0;
        hipGetDevice(&dev);
        hipDeviceGetAttribute(&cus, hipDeviceAttributeMultiprocessorCount, dev);
        hipOccupancyMaxActiveBlocksPerMultiprocessor(&per_cu, mega, 256, SMEM_BYTES);
        if (per_cu < 1) per_cu = 1;
        if (per_cu > 2) per_cu = 2;
        grid_blocks = cus * per_cu;
    }
    hipMemsetAsync(d_ws, 0, 256, stream);
#ifdef DBG_SELFCHECK
    hipMemsetAsync(d_out, 0, 256, stream);
#endif
    Params p{};
    for (int i = 0; i < 25; ++i) p.in[i] = (const float*)d_in[i];
    p.out = (float*)d_out; p.ws = (char*)d_ws; p.ph_lo = 0; p.ph_hi = N_PHASES;
#ifdef DBG_PH_HI
#ifdef DBG_SELFCHECK
    p.ph_hi = DBG_PH_HI + 2;
#else
    p.ph_hi = DBG_PH_HI + 1;
#endif
#endif
    if (ws_size < 980 * MiB) return;
#if defined(MK_SPLIT)
    hipError_t e = hipSuccess;
    launch_phase<99>(p, 0, grid_blocks, stream);
    int nrun = 0;
#ifdef DBG_SPLIT_STOP
    const int nmax = DBG_SPLIT_STOP;
#else
    const int nmax = 30;
#endif
#define LP(K) if (nrun++ < nmax) launch_phase<K>(p, l, grid_blocks, stream)
    for (int l = 0; l < 2; ++l) {
        LP(0); LP(1); LP(2); LP(3); LP(4); LP(5); LP(6); LP(7); LP(14); LP(8); LP(9); LP(10); LP(11); LP(12); LP(13);
    }
#ifdef DBG_SPLIT_STOP
    hipLaunchKernelGGL(dump_kernel, dim3(grid_blocks), dim3(256), 0, stream, p);
#endif
#elif defined(MK_MULTI)
    hipError_t e = hipSuccess;

    const int nph = p.ph_hi;
    for (int ph = 0; ph < nph; ++ph) {
        p.ph_lo = ph; p.ph_hi = ph + 1;
        hipLaunchKernelGGL(mega, dim3(grid_blocks), dim3(256), SMEM_BYTES, stream, p);
    }
#else
    void* args[] = {&p};
    hipError_t e = hipLaunchCooperativeKernel((void*)mega, dim3(grid_blocks), dim3(256), args, SMEM_BYTES, stream);
#endif
    if (e != hipSuccess) fprintf(stderr, "cooperative launch failed: %s (grid %d)\n", hipGetErrorString(e), grid_blocks);
}
```

```cpp
#include <hip/hip_runtime.h>
#include <hip/hip_cooperative_groups.h>
#include <cstdio>
#include <cstdint>
namespace cg = cooperative_groups;

typedef unsigned short bf16_t;
typedef short bf16x8 __attribute__((ext_vector_type(8)));
typedef short s16x4 __attribute__((ext_vector_type(4)));
typedef float f32x4 __attribute__((ext_vector_type(4)));
typedef unsigned u32x4 __attribute__((ext_vector_type(4)));
typedef unsigned u32x2 __attribute__((ext_vector_type(2)));
#define LDS __attribute__((address_space(3)))
typedef LDS char lds_char;
#define DEV __device__ __forceinline__

constexpr int SEQ = 8192, NB = 8, DM = 1024, NTOK = NB * SEQ;
constexpr int SMEM_BYTES = 77824;
constexpr float ALPHA = 1.41421356237309515f;
constexpr float LOG2E = 1.44269504088896341f;
constexpr float LN2 = 0.69314718055994531f;

constexpr size_t MiB = 1048576;
constexpr size_t WL_ELEMS = 24510464;
constexpr size_t OFF_WT = 1 * MiB;
constexpr size_t OFF_MEMB = 100 * MiB;
constexpr size_t OFF_MEMKV = 964 * MiB;
constexpr size_t OFF_XB = 120 * MiB;
constexpr size_t OFF_AQ = 248 * MiB, OFF_AK = 312 * MiB, OFF_AV = 376 * MiB, OFF_RX = 440 * MiB, OFF_RG = 568 * MiB,
                 OFF_CQ = 696 * MiB, OFF_CK = 760 * MiB, OFF_CV = 824 * MiB, OFF_OC = 888 * MiB, OFF_LSE = 952 * MiB,
                 OFF_LA = 954 * MiB, OFF_LH = 958 * MiB;
constexpr size_t OFF_MERGED = OFF_RX, OFF_QX = OFF_AK, OFF_HMID = OFF_AQ;
constexpr size_t W_IN = 0, W_BRA = 8388608, W_BRB = 8912896, W_BRC = 9961472, W_OUT = 10485760, W_XQ = 11534336,
                 W_XKV = 12582912, W_XO = 14680064, W_UP = 15728640, W_DOWN = 21495808, W_GW = 24379392;

struct Params {
    const float* in[25];
    float* out;
    char* ws;
    int ph_lo, ph_hi;
};
typedef const __attribute__((address_space(4))) Params CParams;
enum { I_X = 0, I_MEM, I_WIN, I_LAMQK, I_SUBLN, I_CONVW, I_CONVB, I_GATEW, I_GATEB, I_LAMBDA, I_BRA, I_BRB, I_BRC, I_WOUT,
       I_LN1G, I_LN1B, I_XQ, I_XKV, I_XO, I_LN2G, I_LN2B, I_WUP, I_WDOWN, I_LN3G, I_LN3B };

DEV unsigned pk2(float lo, float hi) { unsigned r; asm("v_cvt_pk_bf16_f32 %0, %1, %2" : "=v"(r) : "v"(lo), "v"(hi)); return r; }
DEV float bf2f(bf16_t v) { return __uint_as_float((unsigned)v << 16); }
DEV float bflo(unsigned v) { return __uint_as_float(v << 16); }
DEV float bfhi(unsigned v) { return __uint_as_float(v & 0xffff0000u); }
DEV float fexp2(float x) { return __builtin_amdgcn_exp2f(x); }
DEV float fexp(float x) { return __builtin_amdgcn_exp2f(x * LOG2E); }
DEV float sigmoidf_(float x) { return 1.0f / (1.0f + fexp(-x)); }
DEV int tidx() { int t = __builtin_amdgcn_workitem_id_x(); asm volatile("" : "+v"(t)); return t; }
#ifndef WT_SCOPE
#define WT_SCOPE __HIP_MEMORY_SCOPE_AGENT
#endif
DEV void wt_store8(void* ptr, u32x2 v) { *(u32x2*)ptr = v; }
DEV void wt_store4f(float* ptr, float v) { *ptr = v; }
DEV void wt_store2(bf16_t* ptr, bf16_t v) { *ptr = v; }
DEV void wt_store16(void* ptr, u32x4 v) { *(u32x4*)ptr = v; }
#define MFMA(a, b, c) __builtin_amdgcn_mfma_f32_16x16x32_bf16((a), (b), (c), 0, 0, 0)

DEV u32x4 coh_load16(const bf16_t* ptr) {
    const unsigned long long* q = (const unsigned long long*)ptr;
    const unsigned long long a = __hip_atomic_load(q, __ATOMIC_RELAXED, __HIP_MEMORY_SCOPE_SYSTEM);
    const unsigned long long b = __hip_atomic_load(q + 1, __ATOMIC_RELAXED, __HIP_MEMORY_SCOPE_SYSTEM);
    u32x4 r; r.x = (unsigned)a; r.y = (unsigned)(a >> 32); r.z = (unsigned)b; r.w = (unsigned)(b >> 32); return r;
}
template <int MI, bool COH>
DEV void gemm_gload(const bf16_t* A, int lda, int m0, const bf16_t* Bt, int ldb, int n0, int k0, u32x4 (&ra)[4], u32x4 (&rb)[MI]) {
    const int T = tidx();
#pragma unroll
    for (int i = 0; i < 4; ++i) {
        const int q = i * 256 + T, r = q >> 3, lc = (q & 7) ^ (r & 7);
        if (COH) {
#ifdef DBG_XQ_F32
            { const float* Af = (const float*)A + (size_t)(m0 + r) * lda + k0 + lc * 8; const f32x4 v0 = *(const f32x4*)Af, v1 = *(const f32x4*)(Af + 4); u32x4 t; t.x = pk2(v0[0], v0[1]); t.y = pk2(v0[2], v0[3]); t.z = pk2(v1[0], v1[1]); t.w = pk2(v1[2], v1[3]); ra[i] = t; }
            if (i < MI) rb[i] = *(const u32x4*)(Bt + (size_t)(n0 + r) * ldb + k0 + lc * 8);
            continue;
#endif
            ra[i] = coh_load16(A + (size_t)(m0 + r) * lda + k0 + lc * 8);
            if (i < MI) rb[i] = coh_load16(Bt + (size_t)(n0 + r) * ldb + k0 + lc * 8);
        } else {
            ra[i] = *(const u32x4*)(A + (size_t)(m0 + r) * lda + k0 + lc * 8);
            if (i < MI) rb[i] = *(const u32x4*)(Bt + (size_t)(n0 + r) * ldb + k0 + lc * 8);
        }
    }
}
template <int MI>
DEV void gemm_sstore(lds_char* st, const u32x4 (&ra)[4], const u32x4 (&rb)[MI]) {
    const int T = tidx();
#pragma unroll
    for (int i = 0; i < 4; ++i) {
        const int q = i * 256 + T;
        *(LDS u32x4*)(st + q * 16) = ra[i];
        if (i < MI) *(LDS u32x4*)(st + 16384 + q * 16) = rb[i];
    }
}
template <int MI, bool COH = false>
DEV void gemm_acc(f32x4 (&acc)[MI][4], const bf16_t* A, int lda, int m0, const bf16_t* Bt, int ldb, int n0, int K, lds_char* smem) {
    constexpr int WN = MI / 2;
    const int T = tidx(), lane = T & 63, w = T >> 6, wr = w / WN, wc = w % WN, fr = lane & 15, fq = lane >> 4;
    const int nt = K >> 6;
    u32x4 ra[4], rb[MI];
    gemm_gload<MI, COH>(A, lda, m0, Bt, ldb, n0, 0, ra, rb);
    __syncthreads();
    for (int t = 0; t < nt; ++t) {
        lds_char* a = smem + (t & 1) * 32768;
        lds_char* b = a + 16384;
        gemm_sstore<MI>(a, ra, rb);
        __syncthreads();
        if (t + 1 < nt) gemm_gload<MI, COH>(A, lda, m0, Bt, ldb, n0, (t + 1) * 64, ra, rb);
#pragma unroll
        for (int ks = 0; ks < 2; ++ks) {
            bf16x8 af[MI], bfr[4];
#pragma unroll
            for (int m = 0; m < MI; ++m) { const int r = wr * (MI * 16) + m * 16 + fr; af[m] = *(const LDS bf16x8*)(a + r * 128 + (((ks * 4 + fq) ^ (r & 7)) << 4)); }
#pragma unroll
            for (int n = 0; n < 4; ++n) { const int r = wc * 64 + n * 16 + fr; bfr[n] = *(const LDS bf16x8*)(b + r * 128 + (((ks * 4 + fq) ^ (r & 7)) << 4)); }
            __builtin_amdgcn_s_setprio(1);
#pragma unroll
            for (int m = 0; m < MI; ++m)
#pragma unroll
                for (int n = 0; n < 4; ++n) acc[m][n] = MFMA(bfr[n], af[m], acc[m][n]);
            __builtin_amdgcn_s_setprio(0);
        }
    }
}
template <int MI>
DEV void zero_acc(f32x4 (&acc)[MI][4]) {
#pragma unroll
    for (int m = 0; m < MI; ++m)
#pragma unroll
        for (int n = 0; n < 4; ++n) acc[m][n] = (f32x4){0.f, 0.f, 0.f, 0.f};
}
#define GEMM_IDS_(MI) const int T = tidx(), lane = T & 63, w = T >> 6, wr = w / ((MI) / 2), wc = w % ((MI) / 2), fr = lane & 15, fq = lane >> 4; constexpr int MI_ = (MI); (void)T; (void)lane; (void)w
#define GEMM_IDS GEMM_IDS_(4)
#define CROW(m) (m0 + wr * (MI_ * 16) + (m) * 16 + fr)
#define CCOL(n) (n0 + wc * 64 + (n) * 16 + fq * 4)

template <int MI>
DEV void epi_bf16(const f32x4 (&acc)[MI][4], bf16_t* dst, int ld, int m0, int n0) {
    GEMM_IDS_(MI);
    float one = 1.0f; asm volatile("" : "+v"(one));
#pragma unroll
    for (int m = 0; m < MI; ++m)
#pragma unroll
        for (int n = 0; n < 4; ++n) {
            const f32x4 a = acc[m][n] * one;
            u32x2 v; v.x = pk2(a[0], a[1]); v.y = pk2(a[2], a[3]);
            wt_store8(dst + (size_t)CROW(m) * ld + CCOL(n), v);
        }
}
DEV void epi_res(const f32x4 (&acc)[4][4], const float* res, float* out, int m0, int n0) {
    GEMM_IDS;
#pragma unroll
    for (int m = 0; m < 4; ++m)
#pragma unroll
        for (int n = 0; n < 4; ++n) {
            const size_t o = (size_t)CROW(m) * DM + CCOL(n);
            const f32x4 r = *(const f32x4*)(res + o);
            { f32x4 a = acc[m][n];
#ifdef DBG_SANITIZE
              for (int e = 0; e < 4; ++e) if (!(fabsf(a[e]) < 1e30f)) a[e] = 0.f;
#endif
              const f32x4 y = r * ALPHA + a; wt_store16(out + o, __builtin_bit_cast(u32x4, y)); }
        }
}

DEV void transpose_tile(const float* __restrict__ src, int N, bf16_t* __restrict__ dst, int K, int k0, int n0, lds_char* smem) {
    LDS float* t = (LDS float*)smem;
    const int T = tidx();
    __syncthreads();
#pragma unroll
    for (int i = 0; i < 4; ++i) {
        const int q = i * 256 + T, r = q >> 4, c = (q & 15) * 4;
        const f32x4 v = *(const f32x4*)(src + (size_t)(k0 + r) * N + n0 + c);
        t[r * 65 + c] = v[0]; t[r * 65 + c + 1] = v[1]; t[r * 65 + c + 2] = v[2]; t[r * 65 + c + 3] = v[3];
    }
    __syncthreads();
#pragma unroll
    for (int i = 0; i < 2; ++i) {
        const int q = i * 256 + T, rr = q >> 3, cc = (q & 7) * 8;
        u32x4 v;
        v.x = pk2(t[(cc + 0) * 65 + rr], t[(cc + 1) * 65 + rr]); v.y = pk2(t[(cc + 2) * 65 + rr], t[(cc + 3) * 65 + rr]);
        v.z = pk2(t[(cc + 4) * 65 + rr], t[(cc + 5) * 65 + rr]); v.w = pk2(t[(cc + 6) * 65 + rr], t[(cc + 7) * 65 + rr]);
        wt_store16(dst + (size_t)(n0 + rr) * K + k0 + cc, v);
    }
}
DEV void phase_prep(CParams& p, lds_char* smem) {
    const int G = gridDim.x, bid = blockIdx.x, T = tidx();
    bf16_t* WT = (bf16_t*)(p.ws + OFF_WT);
    for (int u = bid; u < 2 * 5984; u += G) {
        const int l = u / 5984; int t = u % 5984;
        const float* src; size_t doff; int K, N;
        if (t < 2048) { src = p.in[I_WIN] + (size_t)l * 1024 * 8192; doff = W_IN; K = 1024; N = 8192; }
        else if ((t -= 2048) < 128) { src = p.in[I_BRA] + (size_t)l * 512 * 1024; doff = W_BRA; K = 512; N = 1024; }
        else if ((t -= 128) < 256) { src = p.in[I_BRB] + (size_t)l * 1024 * 1024; doff = W_BRB; K = 1024; N = 1024; }
        else if ((t -= 256) < 128) { src = p.in[I_BRC] + (size_t)l * 512 * 1024; doff = W_BRC; K = 512; N = 1024; }
        else if ((t -= 128) < 256) { src = p.in[I_WOUT] + (size_t)l * 1024 * 1024; doff = W_OUT; K = 1024; N = 1024; }
        else if ((t -= 256) < 256) { src = p.in[I_XQ] + (size_t)l * 1024 * 1024; doff = W_XQ; K = 1024; N = 1024; }
        else if ((t -= 256) < 512) { src = p.in[I_XKV] + (size_t)l * 1024 * 2048; doff = W_XKV; K = 1024; N = 2048; }
        else if ((t -= 512) < 256) { src = p.in[I_XO] + (size_t)l * 1024 * 1024; doff = W_XO; K = 1024; N = 1024; }
        else if ((t -= 256) < 1408) { src = p.in[I_WUP] + (size_t)l * 1024 * 5632; doff = W_UP; K = 1024; N = 5632; }
        else if ((t -= 1408) < 704) { src = p.in[I_WDOWN] + (size_t)l * 2816 * 1024; doff = W_DOWN; K = 2816; N = 1024; }
        else { t -= 704; src = p.in[I_GATEW] + (size_t)l * 131072 + (size_t)t * 4096; doff = W_GW + (size_t)t * 4096; K = 64; N = 64; t = 0; }
        const int tn = N >> 6;
        transpose_tile(src, N, WT + (size_t)l * WL_ELEMS + doff, K, (t / tn) * 64, (t % tn) * 64, smem);
    }
    {
        const f32x4* x4 = (const f32x4*)p.in[I_X]; u32x2* xb = (u32x2*)(p.ws + OFF_XB);
        for (size_t i = (size_t)bid * 256 + T; i < (size_t)NTOK * DM / 4; i += (size_t)G * 256) { const f32x4 v = x4[i]; u32x2 o; o.x = pk2(v[0], v[1]); o.y = pk2(v[2], v[3]); wt_store8(&xb[i], o); }
        const f32x4* m4 = (const f32x4*)p.in[I_MEM]; u32x2* mb = (u32x2*)(p.ws + OFF_MEMB);
        for (size_t i = (size_t)bid * 256 + T; i < (size_t)2048 * DM / 4; i += (size_t)G * 256) { const f32x4 v = m4[i]; u32x2 o; o.x = pk2(v[0], v[1]); o.y = pk2(v[2], v[3]); wt_store8(&mb[i], o); }
    }
}

DEV void rot_coef(int pos, float invf, float& c, float& s) {
    const float ang = (float)pos * invf;
    const float n = rintf(ang * 0.15915494309189535f);
    float r = fmaf(-n, 6.2831854820251465f, ang);
    r = fmaf(-n, -1.7484556025237907e-07f, r);
    c = __cosf(r); s = __sinf(r);
}
DEV void phase_u(CParams& p, int l, lds_char* smem) {
    const int G = gridDim.x, bid = blockIdx.x;
    const bf16_t* xb = (const bf16_t*)(p.ws + OFF_XB);
    const bf16_t* WT = (const bf16_t*)(p.ws + OFF_WT) + (size_t)l * WL_ELEMS;
    const int nkv = 0;
#ifdef DBG_U_XQ
    const int nu = 512 * 48 + nkv;
#else
    const int nu = 512 * 40 + nkv;
#endif
    for (int uu = bid; uu < nu; uu += G) {
        f32x4 acc[4][4]; zero_acc<4>(acc);
        if (uu < nkv) {
            const int v = uu, ll = v >> 8, t = v & 255, m0 = (t >> 4) * 128, n0 = (t & 15) * 128;
            gemm_acc<4, false>(acc, (const bf16_t*)(p.ws + OFF_MEMB), 1024, m0, (const bf16_t*)(p.ws + OFF_WT) + (size_t)ll * WL_ELEMS + W_XKV, 1024, n0, 1024, smem);
            epi_bf16<4>(acc, (bf16_t*)(p.ws + OFF_MEMKV) + (size_t)ll * 2048 * 2048, 2048, m0, n0);
            continue;
        }
        const int u = uu - nkv;
#ifdef DBG_U_XQ
        const int m0 = (u / 48) * 128, n0 = (u % 48) * 128;
        gemm_acc<4>(acc, xb, 1024, m0, (n0 < 5120) ? (WT + W_IN) : (WT + (W_XQ - (size_t)5120 * 1024)), 1024, n0, 1024, smem);
        if (n0 >= 5120) { if (m0 < 16384) epi_bf16<4>(acc, (bf16_t*)(p.ws + 984 * MiB), 1024, m0, n0 - 5120); continue; }
#else
        const int m0 = (u / 40) * 128, n0 = (u % 40) * 128;
        gemm_acc<4>(acc, xb, 1024, m0, WT + W_IN, 1024, n0, 1024, smem);
#endif
        bf16_t* dst; int ld, c0; bool rot = false;
        if (n0 < 512) { dst = (bf16_t*)(p.ws + OFF_AQ); ld = 512; c0 = n0; rot = true; }
        else if (n0 < 1024) { dst = (bf16_t*)(p.ws + OFF_AK); ld = 512; c0 = n0 - 512; rot = true; }
        else if (n0 < 1536) { dst = (bf16_t*)(p.ws + OFF_AV); ld = 512; c0 = n0 - 1024; }
        else if (n0 < 2560) { dst = (bf16_t*)(p.ws + OFF_RX); ld = 1024; c0 = n0 - 1536; }
        else if (n0 < 3584) { dst = (bf16_t*)(p.ws + OFF_RG); ld = 1024; c0 = n0 - 2560; }
        else if (n0 < 4096) { dst = (bf16_t*)(p.ws + OFF_CQ); ld = 512; c0 = n0 - 3584; rot = true; }
        else if (n0 < 4608) { dst = (bf16_t*)(p.ws + OFF_CK); ld = 512; c0 = n0 - 4096; rot = true; }
        else { dst = (bf16_t*)(p.ws + OFF_CV); ld = 512; c0 = n0 - 4608; }
        GEMM_IDS;
        if (rot) {
            const bool hi = (fq & 2) != 0, odd = (fq & 1) != 0;
            const float f0 = odd ? 0.001414213562373095f : 1.0f, f1 = odd ? 0.0002742481756762073f : 0.19392274474868576f,
                        f2 = odd ? 5.318295896944988e-05f : 0.03760603093086393f, f3 = odd ? 1.031338537721246e-05f : 0.007292664737217109f;
#pragma unroll
            for (int m = 0; m < 4; ++m) {
                const int pos = CROW(m) & (SEQ - 1);
                f32x4 v = acc[m][0], o;
#pragma unroll
                for (int j = 0; j < 4; ++j) {
                    const float pv = __shfl_xor(v[j], 32);
                    float c, s; rot_coef(pos, j == 0 ? f0 : j == 1 ? f1 : j == 2 ? f2 : f3, c, s);
                    o[j] = hi ? (v[j] * c + pv * s) : (v[j] * c - pv * s);
                }
                acc[m][0] = o;
            }
        }
        epi_bf16<4>(acc, dst, ld, m0, c0);
    }
}

template <int D, int DV, int KW, int MT, int MODE, bool PF>
DEV void flash_core(const bf16_t* __restrict__ Qp, int ldq, int qtok0, int qstride, int qrow0,
                    const bf16_t* __restrict__ Kp, int ldk, const bf16_t* __restrict__ Vp, int ldv, int ktok0, int kstride,
                    int kt_begin, int kt_end, int koff, float sc, int qpos0, lds_char* smem,
                    f32x4 (&o)[MT][DV / 16], float (&mrow)[MT], float (&lrow)[MT]) {
    const int T = tidx(), lane = T & 63, fr = lane & 15, fq = lane >> 4;
    constexpr int KSTR = KW * 2 + 16, VSTR = DV * 2 + 32;
    lds_char* Ks = smem;
    lds_char* Vs = smem + 64 * KSTR;
    constexpr int KCH = KW / 8, NKL = 64 * KCH / 256, VCH = DV / 8, NVL = 64 * VCH / 256;
    bf16x8 qf[MT][D / 32];
#pragma unroll
    for (int mt = 0; mt < MT; ++mt)
#pragma unroll
        for (int ks = 0; ks < D / 32; ++ks)
            qf[mt][ks] = *(const bf16x8*)(Qp + (size_t)(qtok0 + (qrow0 + mt * 16 + fr) * qstride) * ldq + ks * 32 + fq * 8);
#pragma unroll
    for (int mt = 0; mt < MT; ++mt) {
        mrow[mt] = -1e30f; lrow[mt] = 0.f;
#pragma unroll
        for (int dt = 0; dt < DV / 16; ++dt) o[mt][dt] = (f32x4){0.f, 0.f, 0.f, 0.f};
    }
    u32x4 kreg[NKL], vreg[NVL];
    if (PF && kt_begin < kt_end) {
#pragma unroll
        for (int i = 0; i < NKL; ++i) { const int q = i * 256 + T, row = q / KCH, ch = q % KCH; kreg[i] = *(const u32x4*)(Kp + (size_t)(ktok0 + (kt_begin * 64 + row) * kstride) * ldk + ch * 8); }
#pragma unroll
        for (int i = 0; i < NVL; ++i) { const int q = i * 256 + T, row = q / VCH, ch = q % VCH; vreg[i] = *(const u32x4*)(Vp + (size_t)(ktok0 + (kt_begin * 64 + row) * kstride) * ldv + ch * 8); }
    }
    const int vbase = (4 * fq + ((lane >> 2) & 3)) * VSTR + (lane & 3) * 8;
    for (int kt = kt_begin; kt < kt_end; ++kt) {
        if (!PF) {
#pragma unroll
            for (int i = 0; i < NKL; ++i) { const int q = i * 256 + T, row = q / KCH, ch = q % KCH; kreg[i] = *(const u32x4*)(Kp + (size_t)(ktok0 + (kt * 64 + row) * kstride) * ldk + ch * 8); }
#pragma unroll
            for (int i = 0; i < NVL; ++i) { const int q = i * 256 + T, row = q / VCH, ch = q % VCH; vreg[i] = *(const u32x4*)(Vp + (size_t)(ktok0 + (kt * 64 + row) * kstride) * ldv + ch * 8); }
        }
        __syncthreads();
#pragma unroll
        for (int i = 0; i < NKL; ++i) { const int q = i * 256 + T, row = q / KCH, ch = q % KCH; *(LDS u32x4*)(Ks + row * KSTR + ch * 16) = kreg[i]; }
#pragma unroll
        for (int i = 0; i < NVL; ++i) { const int q = i * 256 + T, row = q / VCH, ch = q % VCH; *(LDS u32x4*)(Vs + row * VSTR + ch * 16) = vreg[i]; }
        __syncthreads();
        if (PF && kt + 1 < kt_end) {
#pragma unroll
            for (int i = 0; i < NKL; ++i) { const int q = i * 256 + T, row = q / KCH, ch = q % KCH; kreg[i] = *(const u32x4*)(Kp + (size_t)(ktok0 + ((kt + 1) * 64 + row) * kstride) * ldk + ch * 8); }
#pragma unroll
            for (int i = 0; i < NVL; ++i) { const int q = i * 256 + T, row = q / VCH, ch = q % VCH; vreg[i] = *(const u32x4*)(Vp + (size_t)(ktok0 + ((kt + 1) * 64 + row) * kstride) * ldv + ch * 8); }
        }
        bool act = true;
        if (MODE == 1) act = (64 * kt + 63 >= qrow0) && (64 * kt <= qrow0 + MT * 16 - 1 + 128);
        if (act) {
            const bool domask = (MODE == 0) ? (kt == kt_end - 1) : (MODE == 1);
            bf16x8 pf[MT][2];
#pragma unroll
            for (int mt = 0; mt < MT; ++mt) {
                f32x4 s[4];
#pragma unroll
                for (int n = 0; n < 4; ++n) s[n] = (f32x4){0.f, 0.f, 0.f, 0.f};
#pragma unroll
                for (int ks = 0; ks < D / 32; ++ks) {
#pragma unroll
                    for (int n = 0; n < 4; ++n) {
                        const bf16x8 kf = *(const LDS bf16x8*)(Ks + (n * 16 + fr) * KSTR + (koff + ks * 32 + fq * 8) * 2);
                        s[n] = MFMA(kf, qf[mt][ks], s[n]);
                    }
                }
                const int qi = qrow0 + mt * 16 + fr;
                float mx = -INFINITY;
#pragma unroll
                for (int n = 0; n < 4; ++n)
#pragma unroll
                    for (int j = 0; j < 4; ++j) {
                        float v = s[n][j] * sc;
                        if (domask) {
                            const int kj = kt * 64 + n * 16 + fq * 4 + j;
                            bool ok;
                            if (MODE == 0) ok = kj <= qpos0 + qi; else ok = (kj >= qi) && (kj <= qi + 128);
                            if (!ok) v = -INFINITY;
                        }
                        s[n][j] = v; mx = fmaxf(mx, v);
                    }
                mx = fmaxf(mx, __shfl_xor(mx, 16)); mx = fmaxf(mx, __shfl_xor(mx, 32));
                const float mn = fmaxf(mrow[mt], mx);
                const float alpha = fexp2(mrow[mt] - mn);
                mrow[mt] = mn;
                float rs = 0.f;
#pragma unroll
                for (int n = 0; n < 4; ++n)
#pragma unroll
                    for (int j = 0; j < 4; ++j) { const float pe = fexp2(s[n][j] - mn); s[n][j] = pe; rs += pe; }
                lrow[mt] = lrow[mt] * alpha + rs;
#pragma unroll
                for (int dt = 0; dt < DV / 16; ++dt) o[mt][dt] *= alpha;
#pragma unroll
                for (int k2 = 0; k2 < 2; ++k2) {
                    u32x4 t;
                    t.x = pk2(s[2 * k2][0], s[2 * k2][1]); t.y = pk2(s[2 * k2][2], s[2 * k2][3]);
                    t.z = pk2(s[2 * k2 + 1][0], s[2 * k2 + 1][1]); t.w = pk2(s[2 * k2 + 1][2], s[2 * k2 + 1][3]);
                    pf[mt][k2] = __builtin_bit_cast(bf16x8, t);
                }
            }
#pragma unroll
            for (int k2 = 0; k2 < 2; ++k2)
#pragma unroll
                for (int dt = 0; dt < DV / 16; ++dt) {
                    const s16x4 v0 = __builtin_amdgcn_ds_read_tr16_b64_v4i16((LDS s16x4*)(Vs + vbase + (k2 * 32) * VSTR + dt * 32));
                    const s16x4 v1 = __builtin_amdgcn_ds_read_tr16_b64_v4i16((LDS s16x4*)(Vs + vbase + (k2 * 32 + 16) * VSTR + dt * 32));
                    const bf16x8 vf = __builtin_shufflevector(v0, v1, 0, 1, 2, 3, 4, 5, 6, 7);
#pragma unroll
                    for (int mt = 0; mt < MT; ++mt) o[mt][dt] = MFMA(vf, pf[mt][k2], o[mt][dt]);
                }
        }
    }
}

DEV void diff_unit(CParams& p, int l, int unit, lds_char* smem) {
    const int T = tidx(), lane = T & 63, w = T >> 6, fr = lane & 15, fq = lane >> 4;
    const int qt = 127 - (unit >> 5), bh = unit & 31, b = bh >> 2, h = bh & 3;
    const int comp = w >> 1, qrow0 = (w & 1) * 32;
    f32x4 o[2][8]; float mrow[2], lrow[2];
    bf16_t* aq = (bf16_t*)(p.ws + OFF_AQ);
    flash_core<64, 128, 128, 2, 0, false>(aq + h * 128 + comp * 64, 512, b * SEQ + qt * 64, 1, qrow0,
                                   (const bf16_t*)(p.ws + OFF_AK) + h * 128, 512, (const bf16_t*)(p.ws + OFF_AV) + h * 128, 512, b * SEQ, 1,
                                   0, qt + 1, comp * 64, 0.125f * LOG2E, qt * 64, smem, o, mrow, lrow);
    int l2 = l; asm volatile("" : "+s"(l2));
    const float linit = (l2 == 0) ? 0.2f : 0.35550906759096934f;
    float lam;
    {
        const float* lq = p.in[I_LAMQK] + l2 * 256;
        float s1 = lq[lane] * lq[64 + lane], s2 = lq[128 + lane] * lq[192 + lane];
#pragma unroll
        for (int o = 32; o >= 1; o >>= 1) { s1 += __shfl_xor(s1, o); s2 += __shfl_xor(s2, o); }
        lam = expf(s1) - expf(s2) + linit;
    }
#pragma unroll
    for (int mt = 0; mt < 2; ++mt) {
        float lt = lrow[mt]; lt += __shfl_xor(lt, 16); lt += __shfl_xor(lt, 32);
        const float inv = 1.0f / lt;
#pragma unroll
        for (int dt = 0; dt < 8; ++dt) o[mt][dt] *= inv;
    }
    __syncthreads();
    LDS float* X = (LDS float*)smem;
    if (comp == 1) {
#pragma unroll
        for (int mt = 0; mt < 2; ++mt)
#pragma unroll
            for (int dt = 0; dt < 8; ++dt) *(LDS f32x4*)(X + ((w & 1) * 32 + mt * 16 + fr) * 132 + dt * 16 + fq * 4) = o[mt][dt];
    }
    __syncthreads();
    if (comp == 0) {
        const float* g = p.in[I_SUBLN] + l * 128;
#pragma unroll
        for (int mt = 0; mt < 2; ++mt) {
            float ss = 0.f;
#pragma unroll
            for (int dt = 0; dt < 8; ++dt) {
                const f32x4 o2 = *(const LDS f32x4*)(X + ((w & 1) * 32 + mt * 16 + fr) * 132 + dt * 16 + fq * 4);
                o[mt][dt] = o[mt][dt] - lam * o2;
                ss += o[mt][dt][0] * o[mt][dt][0] + o[mt][dt][1] * o[mt][dt][1] + o[mt][dt][2] * o[mt][dt][2] + o[mt][dt][3] * o[mt][dt][3];
            }
            ss += __shfl_xor(ss, 16); ss += __shfl_xor(ss, 32);
            const float r = rsqrtf(ss * (1.0f / 128.0f) + 1e-5f) * (1.0f - linit);
            bf16_t* dst = aq + (size_t)(b * SEQ + qt * 64 + qrow0 + mt * 16 + fr) * 512 + h * 128 + fq * 4;
#pragma unroll
            for (int dt = 0; dt < 8; ++dt) {
                const f32x4 gg = *(const f32x4*)(g + dt * 16 + fq * 4);
                u32x2 v; v.x = pk2(o[mt][dt][0] * r * gg[0], o[mt][dt][1] * r * gg[1]); v.y = pk2(o[mt][dt][2] * r * gg[2], o[mt][dt][3] * r * gg[3]);
                wt_store8(dst + dt * 16, v);
            }
        }
    }
}

DEV void dil_unit(CParams& p, int pat, int unit, lds_char* smem) {
    const int T = tidx(), lane = T & 63, w = T >> 6, fr = lane & 15, fq = lane >> 4;
    const int dil = (pat == 0) ? 1 : (pat == 1) ? 4 : 16;
    const int bh = unit & 63, b = bh >> 3, head = bh & 7, pn = unit >> 6, ph = pn % dil, n = pn / dil;
    const int qrow0 = w * 32;
    f32x4 o[2][4]; float mrow[2], lrow[2];
    const int qtok0 = b * SEQ + n * 128 * dil + ph, ktok0 = b * SEQ + (n - 1) * 128 * dil + ph;
    flash_core<64, 64, 64, 2, 1, true>((const bf16_t*)(p.ws + OFF_CQ) + head * 64, 512, qtok0, dil, qrow0,
                                 (const bf16_t*)(p.ws + OFF_CK) + head * 64, 512, (const bf16_t*)(p.ws + OFF_CV) + head * 64, 512, ktok0, dil,
                                 (n == 0) ? 2 : 0, 4, 0, 0.125f * LOG2E, 0, smem, o, mrow, lrow);
    bf16_t* oc = (bf16_t*)(p.ws + OFF_OC);
    float* lsebuf = (float*)(p.ws + OFF_LSE);
#pragma unroll
    for (int mt = 0; mt < 2; ++mt) {
        float lt = lrow[mt]; lt += __shfl_xor(lt, 16); lt += __shfl_xor(lt, 32);
        const float inv = 1.0f / lt;
        float lse = (mrow[mt] + log2f(lt)) * LN2;
        const size_t tok = (size_t)qtok0 + (size_t)(qrow0 + mt * 16 + fr) * dil;
        bf16_t* dst = oc + tok * 512 + head * 64 + fq * 4;
        float wn = inv, wo = 0.f;
        if (pat > 0) {
            const float lo = lsebuf[tok * 8 + head];
            const float mxl = fmaxf(lo, lse);
            const float eo = fexp(lo - mxl), en = fexp(lse - mxl);
            const float tot = eo + en;
            wo = eo / tot; wn = inv * en / tot;
            lse = mxl + logf(tot);
        }
#pragma unroll
        for (int dt = 0; dt < 4; ++dt) {
            f32x4 v = o[mt][dt] * wn;
            if (pat > 0) { const u32x2 old = *(const u32x2*)(dst + dt * 16); v[0] += wo * bflo(old.x); v[1] += wo * bfhi(old.x); v[2] += wo * bflo(old.y); v[3] += wo * bfhi(old.y); }
            u32x2 r; r.x = pk2(v[0], v[1]); r.y = pk2(v[2], v[3]);
            wt_store8(dst + dt * 16, r);
        }
        if (pat < 2 && fq == 0) wt_store4f(&lsebuf[tok * 8 + head], lse);
    }
}

DEV void xattn_unit(CParams& p, int l, int unit, lds_char* smem) {
    const int T = tidx(), lane = T & 63, w = T >> 6, fr = lane & 15, fq = lane >> 4;
    const int h = unit & 3, tok0 = (unit >> 2) * 64, b = tok0 / SEQ;
    f32x4 o[1][16]; float mrow[1], lrow[1];
    bf16_t* qx = (bf16_t*)(p.ws + OFF_QX);
    const bf16_t* kv = (const bf16_t*)(p.ws + OFF_MEMKV) + (size_t)l * 2048 * 2048;
    flash_core<256, 256, 256, 1, 2, false>(qx + h * 256, 1024, tok0, 1, w * 16, kv + h * 256, 2048, kv + 1024 + h * 256, 2048, b * 256, 1,
                                    0, 4, 0, 0.0625f * LOG2E, 0, smem, o, mrow, lrow);
    float lt = lrow[0]; lt += __shfl_xor(lt, 16); lt += __shfl_xor(lt, 32);
    const float inv = 1.0f / lt;
    bf16_t* dst = qx + (size_t)(tok0 + w * 16 + fr) * 1024 + h * 256 + fq * 4;
#pragma unroll
    for (int dt = 0; dt < 16; ++dt) {
        u32x2 r; r.x = pk2(o[0][dt][0] * inv, o[0][dt][1] * inv); r.y = pk2(o[0][dt][2] * inv, o[0][dt][3] * inv);
        wt_store8(dst + dt * 16, r);
    }
}

DEV float neg_expm1(float x) {
    if (x > -0.3f) { float r = 1.0f / 720.0f; r = r * x + 1.0f / 120.0f; r = r * x + 1.0f / 24.0f; r = r * x + 1.0f / 6.0f; r = r * x + 0.5f; r = r * x + 1.0f; return -(r * x); }
    return 1.0f - fexp(x);
}
DEV float gelu_tanh(float x) {
    const float y = 0.7978845608028654f * (x + 0.044715f * x * x * x);
    const float t = 1.0f - 2.0f / (fexp(2.0f * y) + 1.0f);
    return 0.5f * x * (1.0f + t);
}
DEV void lru_unit(CParams& p, int l, int unit, int pass, lds_char* smem) {
    const int T = tidx(), lane = T & 63, w = T >> 6, fr = lane & 15, fq = lane >> 4;
    const int grp = unit & 3, c = (unit >> 2) & 127, b = unit >> 9;
    const int nb = grp * 4 + w, ch0 = nb * 64;
    lds_char* Xs = smem + w * 19456;
    lds_char* XCs = Xs + 9728;
    const bf16_t* rx = (const bf16_t*)(p.ws + OFF_RX);
    bf16_t* rg = (bf16_t*)(p.ws + OFF_RG);
    __syncthreads();
    for (int q = lane; q < 536; q += 64) {
        const int r = q >> 3, ch = q & 7, s = c * 64 + r - 3;
        u32x4 v = (u32x4){0u, 0u, 0u, 0u};
        if (s >= 0) v = *(const u32x4*)(rx + ((size_t)b * SEQ + s) * 1024 + ch0 + ch * 8);
        *(LDS u32x4*)(Xs + r * 144 + ch * 16) = v;
    }
    __syncthreads();
    {
        const int ch = lane & 7;
        const float* cw = p.in[I_CONVW] + (size_t)l * 4096 + ch0 + ch * 8;
        const float* cb = p.in[I_CONVB] + (size_t)l * 1024 + ch0 + ch * 8;
        float wv[4][8], bv[8];
#pragma unroll
        for (int e = 0; e < 8; ++e) { bv[e] = cb[e];
#pragma unroll
            for (int tp = 0; tp < 4; ++tp) wv[tp][e] = cw[tp * 1024 + e]; }
#pragma unroll
        for (int it = 0; it < 8; ++it) {
            const int t = it * 8 + (lane >> 3);
            float a[8];
#pragma unroll
            for (int e = 0; e < 8; ++e) a[e] = bv[e];
#pragma unroll
            for (int tp = 0; tp < 4; ++tp) {
                const u32x4 xv = *(const LDS u32x4*)(Xs + (t + tp) * 144 + ch * 16);
                a[0] += bflo(xv.x) * wv[tp][0]; a[1] += bfhi(xv.x) * wv[tp][1]; a[2] += bflo(xv.y) * wv[tp][2]; a[3] += bfhi(xv.y) * wv[tp][3];
                a[4] += bflo(xv.z) * wv[tp][4]; a[5] += bfhi(xv.z) * wv[tp][5]; a[6] += bflo(xv.w) * wv[tp][6]; a[7] += bfhi(xv.w) * wv[tp][7];
            }
            u32x4 ov; ov.x = pk2(a[0], a[1]); ov.y = pk2(a[2], a[3]); ov.z = pk2(a[4], a[5]); ov.w = pk2(a[6], a[7]);
            *(LDS u32x4*)(XCs + t * 144 + ch * 16) = ov;
        }
    }
    __syncthreads();
    const bf16_t* gw = (const bf16_t*)(p.ws + OFF_WT) + (size_t)l * WL_ELEMS + W_GW;
    bf16x8 gf[2][4][2];
#pragma unroll
    for (int g = 0; g < 2; ++g)
#pragma unroll
        for (int nt = 0; nt < 4; ++nt)
#pragma unroll
            for (int ks = 0; ks < 2; ++ks) gf[g][nt][ks] = *(const bf16x8*)(gw + ((size_t)(g * 16 + nb) * 64 + nt * 16 + fr) * 64 + ks * 32 + fq * 8);
    float sp[4], gb0[4], gb1[4], hin[4], atot[4];
#pragma unroll
    for (int nt = 0; nt < 4; ++nt) {
        const int ch = ch0 + nt * 16 + fr;
        const float lam = p.in[I_LAMBDA][l * 1024 + ch];
        const float x = fexp(-lam);
        sp[nt] = (x < 0.03f) ? x * (1.0f + x * (-0.5f + x * (1.0f / 3.0f + x * (-0.25f + x * 0.2f)))) : logf(1.0f + x);
        gb0[nt] = p.in[I_GATEB][l * 2048 + ch]; gb1[nt] = p.in[I_GATEB][l * 2048 + 1024 + ch];
        atot[nt] = 1.0f;
        hin[nt] = (pass == 1) ? ((const float*)(p.ws + OFF_LH))[((size_t)b * 128 + c) * 1024 + ch] : 0.0f;
    }
    for (int m = 0; m < 4; ++m) {
        f32x4 ar[4], ai[4];
#pragma unroll
        for (int nt = 0; nt < 4; ++nt) { ar[nt] = (f32x4){0.f, 0.f, 0.f, 0.f}; ai[nt] = (f32x4){0.f, 0.f, 0.f, 0.f}; }
#pragma unroll
        for (int ks = 0; ks < 2; ++ks) {
            const bf16x8 xa = *(const LDS bf16x8*)(XCs + (m * 16 + fr) * 144 + (ks * 32 + fq * 8) * 2);
#pragma unroll
            for (int nt = 0; nt < 4; ++nt) { ar[nt] = MFMA(xa, gf[0][nt][ks], ar[nt]); ai[nt] = MFMA(xa, gf[1][nt][ks], ai[nt]); }
        }
#pragma unroll
        for (int nt = 0; nt < 4; ++nt) {
            float Pj[4], Hj[4]; float P = 1.0f, Hh = 0.0f;
#pragma unroll
            for (int j = 0; j < 4; ++j) {
                const int tk = m * 16 + fq * 4 + j;
                const float xc = bf2f(*(const LDS bf16_t*)(XCs + tk * 144 + (nt * 16 + fr) * 2));
                const float r = sigmoidf_(ar[nt][j] + gb0[nt]), ig = sigmoidf_(ai[nt][j] + gb1[nt]);
                const float la = -8.0f * r * sp[nt];
                const float a = fexp(la);
                const float u = sqrtf(neg_expm1(2.0f * la)) * (ig * xc);
                Hh = a * Hh + u; P *= a; Pj[j] = P; Hj[j] = Hh;
            }
            float A1 = P, H1 = Hh;
            { const float ta = __shfl_up(A1, 16), th = __shfl_up(H1, 16); if (fq >= 1) { H1 = A1 * th + H1; A1 = A1 * ta; } }
            { const float ta = __shfl_up(A1, 32), th = __shfl_up(H1, 32); if (fq >= 2) { H1 = A1 * th + H1; A1 = A1 * ta; } }
            float Ea = __shfl_up(A1, 16), Eh = __shfl_up(H1, 16);
            if (fq == 0) { Ea = 1.0f; Eh = 0.0f; }
            const float Ta = __shfl(A1, 48 + fr), Th = __shfl(H1, 48 + fr);
            if (pass == 1) {
                const float h0 = Ea * hin[nt] + Eh;
#pragma unroll
                for (int j = 0; j < 4; ++j) {
                    const int tk = m * 16 + fq * 4 + j;
                    const float hv = Pj[j] * h0 + Hj[j];
                    bf16_t* gp = rg + ((size_t)b * SEQ + c * 64 + tk) * 1024 + ch0 + nt * 16 + fr;
                    const float gv = bf2f(*gp);
                    wt_store2(gp, (bf16_t)(pk2(hv * gelu_tanh(gv), 0.f) & 0xffffu));
                }
            }
            hin[nt] = Ta * hin[nt] + Th; atot[nt] *= Ta;
        }
    }
    if (pass == 0 && fq == 0) {
#pragma unroll
        for (int nt = 0; nt < 4; ++nt) {
            const size_t o = ((size_t)b * 128 + c) * 1024 + ch0 + nt * 16 + fr;
            wt_store4f((float*)(p.ws + OFF_LA) + o, atot[nt]); wt_store4f((float*)(p.ws + OFF_LH) + o, hin[nt]);
        }
    }
}
DEV void lru_carry(CParams& p) {
    float* LA = (float*)(p.ws + OFF_LA); float* LH = (float*)(p.ws + OFF_LH);
    for (int i = blockIdx.x * 256 + tidx(); i < NB * 1024; i += gridDim.x * 256) {
        const int b = i >> 10, ch = i & 1023;
        float carry = 0.f;
        for (int c = 0; c < 128; ++c) {
            const size_t o = ((size_t)b * 128 + c) * 1024 + ch;
            const float a = LA[o], h = LH[o];
            wt_store4f(&LH[o], carry); carry = a * carry + h;
        }
    }
}

DEV void phase_mix(CParams& p, int l, int which, lds_char* smem) {
    const int G = gridDim.x, bid = blockIdx.x;
    if (which == 0) {
        for (int u = bid; u < 4096; u += G) diff_unit(p, l, u, smem);
        for (int u = bid; u < 4096; u += G) dil_unit(p, 0, u, smem);
        for (int u = bid; u < 4096; u += G) lru_unit(p, l, u, 0, smem);
    } else if (which == 1) {
        lru_carry(p);
        for (int u = bid; u < 4096; u += G) dil_unit(p, 1, u, smem);
    } else {
        for (int u = bid; u < 4096; u += G) dil_unit(p, 2, u, smem);
#ifndef DBG_NO_LRU1
        for (int u = bid; u < 4096; u += G) lru_unit(p, l, u, 1, smem);
#endif
    }
}

DEV void phase_merge(CParams& p, int l, lds_char* smem) {
    const int G = gridDim.x, bid = blockIdx.x;
    const bf16_t* xb = (const bf16_t*)(p.ws + OFF_XB);
    const bf16_t* WT = (const bf16_t*)(p.ws + OFF_WT) + (size_t)l * WL_ELEMS;
    for (int u = bid; u < 512 * 8; u += G) {
        const int m0 = (u >> 3) * 128, n0 = (u & 7) * 128;
        f32x4 accM[4][4]; zero_acc<4>(accM);
#pragma unroll 1
        for (int i = 0; i < 3; ++i) {
            f32x4 acc[4][4]; zero_acc<4>(acc);
            gemm_acc<4>(acc, xb, 1024, m0, WT + W_IN + (size_t)(5120 + i * 1024) * 1024, 1024, n0, 1024, smem);
            unsigned gp[4][4][2];
#pragma unroll
            for (int m = 0; m < 4; ++m)
#pragma unroll
                for (int n = 0; n < 4; ++n) { gp[m][n][0] = pk2(sigmoidf_(acc[m][n][0]), sigmoidf_(acc[m][n][1])); gp[m][n][1] = pk2(sigmoidf_(acc[m][n][2]), sigmoidf_(acc[m][n][3])); }
            zero_acc<4>(acc);
            const bf16_t* A = (i == 0) ? (const bf16_t*)(p.ws + OFF_AQ) : (i == 1) ? (const bf16_t*)(p.ws + OFF_RG) : (const bf16_t*)(p.ws + OFF_OC);
            const int Ki = (i == 1) ? 1024 : 512;
            const bf16_t* Bt = WT + ((i == 0) ? W_BRA : (i == 1) ? W_BRB : W_BRC);
            gemm_acc<4>(acc, A, Ki, m0, Bt, Ki, n0, Ki, smem);
#pragma unroll
            for (int m = 0; m < 4; ++m)
#pragma unroll
                for (int n = 0; n < 4; ++n) {
                    accM[m][n][0] += bflo(gp[m][n][0]) * acc[m][n][0]; accM[m][n][1] += bfhi(gp[m][n][0]) * acc[m][n][1];
                    accM[m][n][2] += bflo(gp[m][n][1]) * acc[m][n][2]; accM[m][n][3] += bfhi(gp[m][n][1]) * acc[m][n][3];
                }
        }
        epi_bf16<4>(accM, (bf16_t*)(p.ws + OFF_MERGED), 1024, m0, n0);
    }
}
DEV void phase_gemm_res(CParams& p, const bf16_t* A, int K, const bf16_t* Bt, const float* res, lds_char* smem) {
    const int G = gridDim.x, bid = blockIdx.x;
    for (int u = bid; u < 512 * 8; u += G) {
        const int m0 = (u >> 3) * 128, n0 = (u & 7) * 128;
        f32x4 acc[4][4]; zero_acc<4>(acc);
        gemm_acc<4>(acc, A, K, m0, Bt, K, n0, K, smem);
        epi_res(acc, res, p.out, m0, n0);
    }
}
#ifndef XQ_COH
#define XQ_COH false
#endif
DEV void phase_xq(CParams& p, int l, lds_char* smem) {
    const int G = gridDim.x, bid = blockIdx.x;
    const bf16_t* WT = (const bf16_t*)(p.ws + OFF_WT) + (size_t)l * WL_ELEMS;
#ifdef DBG_XQ_DELAY
    { const unsigned long long t0 = __builtin_amdgcn_s_memrealtime(); while (__builtin_amdgcn_s_memrealtime() - t0 < 50000ull) __builtin_amdgcn_s_sleep(8); }
#endif
#ifdef DBG_XQ_A_MERGED
    const bf16_t* xb = (const bf16_t*)(p.ws + OFF_MERGED);
#elif defined(DBG_XB2)
    const bf16_t* xb = (const bf16_t*)(p.ws + 984 * MiB);
#elif defined(DBG_XQ_F32)
    const bf16_t* xb = (const bf16_t*)p.out;
#else
    const bf16_t* xb = (const bf16_t*)(p.ws + OFF_XB);
#endif
#ifndef DBG_XQW
#define DBG_XQW W_XQ
#endif
    const bf16_t* Wq = WT + DBG_XQW;
#ifdef DBG_XB2
    bf16_t* qx = (bf16_t*)(p.ws + OFF_QX);
    for (int u = bid; u < 128 * 8; u += G) {
#elif defined(DBG_QX_ALT)
    bf16_t* qx = (bf16_t*)(p.ws + 984 * MiB);
    for (int u = bid; u < 128 * 8; u += G) {
#else
    bf16_t* qx = (bf16_t*)(p.ws + OFF_QX);
    for (int u = bid; u < 512 * 8; u += G) {
#endif
#ifdef DBG_XQ_MAP2
        const int m0 = (u & 511) * 128, n0 = (u >> 9) * 128;
#else
        const int m0 = (u >> 3) * 128, n0 = (u & 7) * 128;
#endif
        f32x4 acc[4][4]; zero_acc<4>(acc);
        gemm_acc<4, XQ_COH>(acc, xb, 1024, m0, Wq, 1024, n0, 1024, smem);
        epi_bf16<4>(acc, qx, 1024, m0, n0);
    }
}
DEV void phase_memkv(CParams& p, int l, lds_char* smem) {
    const int G = gridDim.x, bid = blockIdx.x;
    const bf16_t* WT = (const bf16_t*)(p.ws + OFF_WT) + (size_t)l * WL_ELEMS;
    for (int t = bid; t < 256; t += G) {
        f32x4 acc[4][4]; zero_acc<4>(acc);
        const int m0 = (t >> 4) * 128, n0 = (t & 15) * 128;
        gemm_acc<4>(acc, (const bf16_t*)(p.ws + OFF_MEMB), 1024, m0, WT + W_XKV, 1024, n0, 1024, smem);
        epi_bf16<4>(acc, (bf16_t*)(p.ws + OFF_MEMKV) + (size_t)l * 2048 * 2048, 2048, m0, n0);
    }
}
DEV void phase_up(CParams& p, int l, lds_char* smem) {
    const int G = gridDim.x, bid = blockIdx.x;
    const bf16_t* WT = (const bf16_t*)(p.ws + OFF_WT) + (size_t)l * WL_ELEMS;
    const bf16_t* xb = (const bf16_t*)(p.ws + OFF_XB);
    for (int u = bid; u < 512 * 22; u += G) {
        const int m0 = (u / 22) * 128, n0 = (u % 22) * 128;
        f32x4 acc[4][4]; zero_acc<4>(acc);
        gemm_acc<4>(acc, xb, 1024, m0, WT + W_UP, 1024, n0, 1024, smem);
        unsigned gp[4][4][2];
#pragma unroll
        for (int m = 0; m < 4; ++m)
#pragma unroll
            for (int n = 0; n < 4; ++n) {
                f32x4 g = acc[m][n];
#pragma unroll
                for (int j = 0; j < 4; ++j) g[j] = g[j] * sigmoidf_(g[j]);
                gp[m][n][0] = pk2(g[0], g[1]); gp[m][n][1] = pk2(g[2], g[3]);
            }
        zero_acc<4>(acc);
        gemm_acc<4>(acc, xb, 1024, m0, WT + W_UP + (size_t)2816 * 1024, 1024, n0, 1024, smem);
#pragma unroll
        for (int m = 0; m < 4; ++m)
#pragma unroll
            for (int n = 0; n < 4; ++n) {
                acc[m][n][0] *= bflo(gp[m][n][0]); acc[m][n][1] *= bfhi(gp[m][n][0]); acc[m][n][2] *= bflo(gp[m][n][1]); acc[m][n][3] *= bfhi(gp[m][n][1]);
            }
        epi_bf16<4>(acc, (bf16_t*)(p.ws + OFF_HMID), 2816, m0, n0);
    }
}

DEV void phase_ln(CParams& p, const float* g, const float* bta) {
    const int lane = tidx() & 63, w = tidx() >> 6;
    f32x4 gv[4], bv[4];
#pragma unroll
    for (int i = 0; i < 4; ++i) { gv[i] = *(const f32x4*)(g + i * 256 + lane * 4); bv[i] = *(const f32x4*)(bta + i * 256 + lane * 4); }
    for (int row = blockIdx.x * 4 + w; row < NTOK; row += gridDim.x * 4) {
        float* xr = p.out + (size_t)row * DM;
        f32x4 v[4]; float s = 0.f;
#pragma unroll
        for (int i = 0; i < 4; ++i) { v[i] = *(const f32x4*)(xr + i * 256 + lane * 4); s += v[i][0] + v[i][1] + v[i][2] + v[i][3]; }
#pragma unroll
        for (int o = 32; o >= 1; o >>= 1) s += __shfl_xor(s, o);
        const float mean = s * (1.0f / 1024.0f);
        float q = 0.f;
#pragma unroll
        for (int i = 0; i < 4; ++i) { v[i] = v[i] - mean; q += v[i][0] * v[i][0] + v[i][1] * v[i][1] + v[i][2] * v[i][2] + v[i][3] * v[i][3]; }
#pragma unroll
        for (int o = 32; o >= 1; o >>= 1) q += __shfl_xor(q, o);
        const float rstd = rsqrtf(q * (1.0f / 1024.0f) + 1e-5f);
        bf16_t* xbr = (bf16_t*)(p.ws + OFF_XB) + (size_t)row * DM;
#pragma unroll
        for (int i = 0; i < 4; ++i) {
            f32x4 y = v[i] * rstd * gv[i] + bv[i];
#ifdef DBG_SANITIZE
            for (int e = 0; e < 4; ++e) if (!(fabsf(y[e]) < 1e30f)) y[e] = 0.f;
#endif
            wt_store16(xr + i * 256 + lane * 4, __builtin_bit_cast(u32x4, y));
            u32x2 r; r.x = pk2(y[0], y[1]); r.y = pk2(y[2], y[3]);
            wt_store8(xbr + i * 256 + lane * 4, r);
#ifdef DBG_XB2
            if (row < 16384) wt_store8((bf16_t*)(p.ws + 984 * MiB) + (size_t)row * DM + i * 256 + lane * 4, r);
#endif
        }
    }
}

#ifdef DBG_PH_HI
#define EN(k) ((k) < DBG_PH_HI - 1)
#else
#define EN(k) 1
#endif
constexpr int PH_PER_LAYER = 14, N_PHASES = 1 + 2 * PH_PER_LAYER;
DEV void run_phase(CParams& p, int ph, lds_char* smem) {
    if (ph == 0) { phase_prep(p, smem); return; }
    const int l = (ph - 1) / PH_PER_LAYER, k = (ph - 1) % PH_PER_LAYER;
    const bf16_t* WT = (const bf16_t*)(p.ws + OFF_WT) + (size_t)l * WL_ELEMS;
    switch (k) {
        case 0:
#if EN(0)
            phase_u(p, l, smem);
#ifdef DBG_XQ_IN_P1
            phase_xq(p, l, smem);
#endif
#endif
            break;
        case 1:
#if EN(1)
            phase_mix(p, l, 0, smem);
#endif
            break;
        case 2:
#if EN(2)
            phase_mix(p, l, 1, smem);
#endif
            break;
        case 3:
#if EN(3)
            phase_mix(p, l, 2, smem);
#endif
            break;
        case 4:
#if EN(4)
            phase_merge(p, l, smem);
#endif
            break;
        case 5:
#if EN(5)
            phase_gemm_res(p, (const bf16_t*)(p.ws + OFF_MERGED), 1024, WT + W_OUT, (l == 0) ? p.in[I_X] : p.out, smem);
#endif
            break;
        case 6:
#if EN(6) && !defined(DBG_SKIP_LN1)
            phase_ln(p, p.in[I_LN1G] + l * 1024, p.in[I_LN1B] + l * 1024);
#endif
            break;
        case 7:
#if EN(7)
            phase_xq(p, l, smem);
            phase_memkv(p, l, smem);
#endif
            break;
        case 8:
#if EN(8)
            for (int u = blockIdx.x; u < 4096; u += gridDim.x) xattn_unit(p, l, u, smem);
#endif
            break;
        case 9:
#if EN(9)
            phase_gemm_res(p, (const bf16_t*)(p.ws + OFF_QX), 1024, WT + W_XO, p.out, smem);
#endif
            break;
        case 10:
#if EN(10)
            phase_ln(p, p.in[I_LN2G] + l * 1024, p.in[I_LN2B] + l * 1024);
#endif
            break;
        case 11:
#if EN(11)
            phase_up(p, l, smem);
#endif
            break;
        case 12:
#if EN(12)
            phase_gemm_res(p, (const bf16_t*)(p.ws + OFF_HMID), 2816, WT + W_DOWN, p.out, smem);
#endif
            break;
        default:
#if EN(13)
            phase_ln(p, p.in[I_LN3G] + l * 1024, p.in[I_LN3B] + l * 1024);
#endif
            break;
    }
}

template <int K>
__global__ void __launch_bounds__(256, 2) phase_kernel(Params p, int l) {
    extern __shared__ __attribute__((aligned(16))) char smem_raw[];
    lds_char* smem = (lds_char*)smem_raw;
    CParams* kp = (CParams*)__builtin_amdgcn_kernarg_segment_ptr();
    CParams& q = *kp;
    const bf16_t* WT = (const bf16_t*)(q.ws + OFF_WT) + (size_t)l * WL_ELEMS;
    if (K == 99) phase_prep(q, smem);
    else if (K == 0) phase_u(q, l, smem);
    else if (K == 1) phase_mix(q, l, 0, smem);
    else if (K == 2) phase_mix(q, l, 1, smem);
    else if (K == 3) phase_mix(q, l, 2, smem);
    else if (K == 4) phase_merge(q, l, smem);
    else if (K == 5) phase_gemm_res(q, (const bf16_t*)(q.ws + OFF_MERGED), 1024, WT + W_OUT, (l == 0) ? q.in[I_X] : q.out, smem);
    else if (K == 6) phase_ln(q, q.in[I_LN1G] + l * 1024, q.in[I_LN1B] + l * 1024);
    else if (K == 7) phase_xq(q, l, smem);
    else if (K == 14) phase_memkv(q, l, smem);
    else if (K == 8) { for (int u = blockIdx.x; u < 4096; u += gridDim.x) xattn_unit(q, l, u, smem); }
    else if (K == 9) phase_gemm_res(q, (const bf16_t*)(q.ws + OFF_QX), 1024, WT + W_XO, q.out, smem);
    else if (K == 10) phase_ln(q, q.in[I_LN2G] + l * 1024, q.in[I_LN2B] + l * 1024);
    else if (K == 11) phase_up(q, l, smem);
    else if (K == 12) phase_gemm_res(q, (const bf16_t*)(q.ws + OFF_HMID), 2816, WT + W_DOWN, q.out, smem);
    else phase_ln(q, q.in[I_LN3G] + l * 1024, q.in[I_LN3B] + l * 1024);
}
#ifdef DBG_SPLIT_STOP
__global__ void __launch_bounds__(256, 2) dump_kernel(Params p) {
    const size_t NW = DBG_NW;
    for (size_t i = (size_t)blockIdx.x * 256 + threadIdx.x; i < 3 * NW; i += (size_t)gridDim.x * 256) {
        const size_t r = i / NW, j = i % NW;
        const size_t off = (r == 0) ? (size_t)DBG_DUMP_OFF : (r == 1) ? (size_t)DBG_DUMP_OFF2 : (size_t)DBG_DUMP_OFF3;
#ifdef DBG_DUMP_F32
        float a0 = p.out[2 * i], a1 = p.out[2 * i + 1];
#else
        const unsigned v = ((const unsigned*)(p.ws + off))[j]; float a0 = bflo(v), a1 = bfhi(v);
#endif
        const float mk = (r == 0) ? 1.0e3f : (r == 1) ? 1.0e5f : 1.0e7f;
        if (!(fabsf(a0) < 1e30f)) a0 = mk; if (!(fabsf(a1) < 1e30f)) a1 = mk;
        p.out[2 * i] = a0; p.out[2 * i + 1] = a1;
    }
}
#endif
template <int K>
static void launch_phase(const Params& p, int l, int grid, hipStream_t stream) {
    hipFuncSetAttribute((const void*)phase_kernel<K>, hipFuncAttributeMaxDynamicSharedMemorySize, SMEM_BYTES);
    hipLaunchKernelGGL(phase_kernel<K>, dim3(grid), dim3(256), SMEM_BYTES, stream, p, l);
}
__global__ void __launch_bounds__(256, 2) mega(Params p) {
    extern __shared__ __attribute__((aligned(16))) char smem_raw[];
    lds_char* smem = (lds_char*)smem_raw;
    cg::grid_group grid = cg::this_grid();
    const int ph_lo = p.ph_lo, ph_hi = p.ph_hi;
    unsigned nbar = 0;
    if (ph_lo < 0) grid.sync();
    for (int ph = ph_lo; ph < ph_hi; ++ph) {
        CParams* kp = (CParams*)__builtin_amdgcn_kernarg_segment_ptr();
        asm volatile("" : "+s"(kp));
#ifdef DBG_SELFCHECK
        if (ph == DBG_PH_HI + 1) {
            if (blockIdx.x == 0 && tidx() == 0) {
                const unsigned c = __hip_atomic_load((unsigned*)(kp->ws + 64), __ATOMIC_RELAXED, __HIP_MEMORY_SCOPE_AGENT);
                const float b = (float)((c + 16384u) / 32768u);
                kp->out[0] = 1.0e6f * b + 7.0e5f * (float)(c < 1000000u ? c : 999999u) / 1.0e6f * 0.f;
            }
        } else
#endif
#if defined(DBG_DUMP_OFF) && defined(DBG_PH_HI)
        if (ph == DBG_PH_HI) {
#ifndef DBG_NW
#define DBG_NW 10485760
#endif
#ifndef DBG_COLEXPR
#define DBG_COLEXPR (((int)(i & 15) * 61 + (int)(row & 63)) % DBG_NCOL)
#endif
#ifdef DBG_SELFCHECK
            {
                const bf16_t* Ap = (const bf16_t*)(kp->ws + DBG_A_OFF);
                const bf16_t* Wp = (const bf16_t*)(kp->ws + OFF_WT) + DBG_W_OFF;
                const bf16_t* Cp = (const bf16_t*)(kp->ws + DBG_C_OFF);
                for (size_t i = (size_t)blockIdx.x * 256 + tidx(); i < (size_t)DBG_ROWS * 16; i += (size_t)gridDim.x * 256) {
                    const size_t row = i >> 4; const int col = DBG_COLEXPR;
                    float acc = 0.f;
                    for (int k = 0; k < 1024; ++k) {
#ifdef DBG_A_FROM_X
                        const float av = bflo(pk2(kp->in[I_X][row * 1024 + k], 0.f));
#elif defined(DBG_A_FROM_OUT)
                        const float av = bflo(pk2(kp->out[row * 1024 + k], 0.f));
#else
                        const float av = bf2f(Ap[row * 1024 + k]);
#endif
                        acc += av * bf2f(Wp[(size_t)col * 1024 + k]); }
                    const float st = bf2f(Cp[row * DBG_LDC + col]);
                    if (!(fabsf(acc - st) <= 0.02f + 0.02f * fabsf(acc))) atomicAdd((unsigned*)(kp->ws + 64), 1u);
                }
            }
#else
            const size_t NW = DBG_NW;
            for (size_t i = (size_t)blockIdx.x * 256 + tidx(); i < 3 * NW; i += (size_t)gridDim.x * 256) {
                const size_t r = i / NW, j = i % NW;
                const size_t off = (r == 0) ? (size_t)DBG_DUMP_OFF : (r == 1) ? (size_t)DBG_DUMP_OFF2 : (size_t)DBG_DUMP_OFF3;
                const unsigned v = ((const unsigned*)(kp->ws + off))[j]; { float a0 = bflo(v), a1 = bfhi(v); if (!(fabsf(a0) < 1e30f)) a0 = 12345.0f; if (!(fabsf(a1) < 1e30f)) a1 = 12345.0f; kp->out[2 * i] = a0; kp->out[2 * i + 1] = a1; }
            }
#endif
        } else
#endif
        run_phase(*kp, ph, smem);
        if (ph + 1 < ph_hi) {
#ifdef DBG_SKEW
            if ((blockIdx.x & 15) == 3) { const unsigned long long t0 = __builtin_amdgcn_s_memrealtime(); while (__builtin_amdgcn_s_memrealtime() - t0 < 30000ull) __builtin_amdgcn_s_sleep(8); }
#endif
            asm volatile("s_waitcnt vmcnt(0)" ::: "memory");
            __syncthreads();
            ++nbar;
            if (tidx() == 0) {
                __builtin_amdgcn_fence(__ATOMIC_RELEASE, "agent");
                asm volatile("s_waitcnt vmcnt(0)" ::: "memory");
                unsigned* ctr = (unsigned*)kp->ws;
                __hip_atomic_fetch_add(ctr, 1u, __ATOMIC_RELAXED, __HIP_MEMORY_SCOPE_AGENT);
                const unsigned target = nbar * gridDim.x;
                while (__hip_atomic_load(ctr, __ATOMIC_RELAXED, __HIP_MEMORY_SCOPE_AGENT) < target) __builtin_amdgcn_s_sleep(2);
            }
            __syncthreads();
            __builtin_amdgcn_fence(__ATOMIC_ACQUIRE, "agent");
        }
    }
}

extern "C" void kernel_launch(void* const* d_in, const int* in_sizes, int n_in, void* d_out, int out_size, void* d_ws, size_t ws_size, hipStream_t stream) {
    static int grid_blocks = 0;
    hipFuncSetAttribute((const void*)mega, hipFuncAttributeMaxDynamicSharedMemorySize, SMEM_BYTES);
    if (!grid_blocks) {
        int dev = 0, cus = 0, per_cu = 0;
        hipGetDevice(&dev);
        hipDeviceGetAttribute(&cus, hipDeviceAttributeMultiprocessorCount, dev);
        hipOccupancyMaxActiveBlocksPerMultiprocessor(&per_cu, mega, 256, SMEM_BYTES);
        if (per_cu < 1) per_cu = 1;
        if (per_cu > 2) per_cu = 2;
        grid_blocks = cus * per_cu;
    }
    hipMemsetAsync(d_ws, 0, 256, stream);
#ifdef DBG_SELFCHECK
    hipMemsetAsync(d_out, 0, 256, stream);
#endif
    Params p{};
    for (int i = 0; i < 25; ++i) p.in[i] = (const float*)d_in[i];
    p.out = (float*)d_out; p.ws = (char*)d_ws; p.ph_lo = 0; p.ph_hi = N_PHASES;
#ifdef DBG_PH_HI
#ifdef DBG_SELFCHECK
    p.ph_hi = DBG_PH_HI + 2;
#else
    p.ph_hi = DBG_PH_HI + 1;
#endif
#endif
    if (ws_size < 980 * MiB) return;
#if defined(MK_SPLIT)
    hipError_t e = hipSuccess;
    launch_phase<99>(p, 0, grid_blocks, stream);
    int nrun = 0;
#ifdef DBG_SPLIT_STOP
    const int nmax = DBG_SPLIT_STOP;
#else
    const int nmax = 30;
#endif
#define LP(K) if (nrun++ < nmax) launch_phase<K>(p, l, grid_blocks, stream)
    for (int l = 0; l < 2; ++l) {
        LP(0); LP(1); LP(2); LP(3); LP(4); LP(5); LP(6); LP(7); LP(14); LP(8); LP(9); LP(10); LP(11); LP(12); LP(13);
    }
#ifdef DBG_SPLIT_STOP
    hipLaunchKernelGGL(dump_kernel, dim3(grid_blocks), dim3(256), 0, stream, p);
#endif
#elif defined(MK_MULTI)
    hipError_t e = hipSuccess;

    const int nph = p.ph_hi;
    for (int ph = 0; ph < nph; ++ph) {
        p.ph_lo = ph; p.ph_hi = ph + 1;
        hipLaunchKernelGGL(mega, dim3(grid_blocks), dim3(256), SMEM_BYTES, stream, p);
    }
#else
    void* args[] = {&p};
    hipError_t e = hipLaunchCooperativeKernel((void*)mega, dim3(grid_blocks), dim3(256), args, SMEM_BYTES, stream);
#endif
    if (e != hipSuccess) fprintf(stderr, "cooperative launch failed: %s (grid %d)\n", hipGetErrorString(e), grid_blocks);
}
```

```cpp
#include <hip/hip_runtime.h>
#include <hip/hip_cooperative_groups.h>
#include <cstdio>
#include <cstdint>
namespace cg = cooperative_groups;

typedef unsigned short bf16_t;
typedef short bf16x8 __attribute__((ext_vector_type(8)));
typedef short s16x4 __attribute__((ext_vector_type(4)));
typedef float f32x4 __attribute__((ext_vector_type(4)));
typedef unsigned u32x4 __attribute__((ext_vector_type(4)));
typedef unsigned u32x2 __attribute__((ext_vector_type(2)));
#define LDS __attribute__((address_space(3)))
typedef LDS char lds_char;
#define DEV __device__ __forceinline__

constexpr int SEQ = 8192, NB = 8, DM = 1024, NTOK = NB * SEQ;
constexpr int SMEM_BYTES = 77824;
constexpr float ALPHA = 1.41421356237309515f;
constexpr float LOG2E = 1.44269504088896341f;
constexpr float LN2 = 0.69314718055994531f;

constexpr size_t MiB = 1048576;
constexpr size_t WL_ELEMS = 24510464;
constexpr size_t OFF_WT = 1 * MiB;
constexpr size_t OFF_MEMB = 100 * MiB;
constexpr size_t OFF_MEMKV = 964 * MiB;
constexpr size_t OFF_XB = 120 * MiB;
constexpr size_t OFF_AQ = 248 * MiB, OFF_AK = 312 * MiB, OFF_AV = 376 * MiB, OFF_RX = 440 * MiB, OFF_RG = 568 * MiB,
                 OFF_CQ = 696 * MiB, OFF_CK = 760 * MiB, OFF_CV = 824 * MiB, OFF_OC = 888 * MiB, OFF_LSE = 952 * MiB,
                 OFF_LA = 954 * MiB, OFF_LH = 958 * MiB;
constexpr size_t OFF_MERGED = OFF_RX, OFF_QX = OFF_AK, OFF_HMID = OFF_AQ;
constexpr size_t W_IN = 0, W_BRA = 8388608, W_BRB = 8912896, W_BRC = 9961472, W_OUT = 10485760, W_XQ = 11534336,
                 W_XKV = 12582912, W_XO = 14680064, W_UP = 15728640, W_DOWN = 21495808, W_GW = 24379392;

struct Params {
    const float* in[25];
    float* out;
    char* ws;
    int ph_lo, ph_hi;
};
typedef const __attribute__((address_space(4))) Params CParams;
enum { I_X = 0, I_MEM, I_WIN, I_LAMQK, I_SUBLN, I_CONVW, I_CONVB, I_GATEW, I_GATEB, I_LAMBDA, I_BRA, I_BRB, I_BRC, I_WOUT,
       I_LN1G, I_LN1B, I_XQ, I_XKV, I_XO, I_LN2G, I_LN2B, I_WUP, I_WDOWN, I_LN3G, I_LN3B };

DEV unsigned pk2(float lo, float hi) { unsigned r; asm("v_cvt_pk_bf16_f32 %0, %1, %2" : "=v"(r) : "v"(lo), "v"(hi)); return r; }
DEV float bf2f(bf16_t v) { return __uint_as_float((unsigned)v << 16); }
DEV float bflo(unsigned v) { return __uint_as_float(v << 16); }
DEV float bfhi(unsigned v) { return __uint_as_float(v & 0xffff0000u); }
DEV float fexp2(float x) { return __builtin_amdgcn_exp2f(x); }
DEV float fexp(float x) { return __builtin_amdgcn_exp2f(x * LOG2E); }
DEV float sigmoidf_(float x) { return 1.0f / (1.0f + fexp(-x)); }
DEV int tidx() { int t = __builtin_amdgcn_workitem_id_x(); asm volatile("" : "+v"(t)); return t; }
#ifndef WT_SCOPE
#define WT_SCOPE __HIP_MEMORY_SCOPE_AGENT
#endif
DEV void wt_store8(void* ptr, u32x2 v) { *(u32x2*)ptr = v; }
DEV void wt_store4f(float* ptr, float v) { *ptr = v; }
DEV void wt_store2(bf16_t* ptr, bf16_t v) { *ptr = v; }
DEV void wt_store16(void* ptr, u32x4 v) { *(u32x4*)ptr = v; }
#define MFMA(a, b, c) __builtin_amdgcn_mfma_f32_16x16x32_bf16((a), (b), (c), 0, 0, 0)

DEV u32x4 coh_load16(const bf16_t* ptr) {
    const unsigned long long* q = (const unsigned long long*)ptr;
    const unsigned long long a = __hip_atomic_load(q, __ATOMIC_RELAXED, __HIP_MEMORY_SCOPE_SYSTEM);
    const unsigned long long b = __hip_atomic_load(q + 1, __ATOMIC_RELAXED, __HIP_MEMORY_SCOPE_SYSTEM);
    u32x4 r; r.x = (unsigned)a; r.y = (unsigned)(a >> 32); r.z = (unsigned)b; r.w = (unsigned)(b >> 32); return r;
}
template <int MI, bool COH>
DEV void gemm_gload(const bf16_t* A, int lda, int m0, const bf16_t* Bt, int ldb, int n0, int k0, u32x4 (&ra)[4], u32x4 (&rb)[MI]) {
    const int T = tidx();
#pragma unroll
    for (int i = 0; i < 4; ++i) {
        const int q = i * 256 + T, r = q >> 3, lc = (q & 7) ^ (r & 7);
        if (COH) {
#ifdef DBG_XQ_F32
            { const float* Af = (const float*)A + (size_t)(m0 + r) * lda + k0 + lc * 8; const f32x4 v0 = *(const f32x4*)Af, v1 = *(const f32x4*)(Af + 4); u32x4 t; t.x = pk2(v0[0], v0[1]); t.y = pk2(v0[2], v0[3]); t.z = pk2(v1[0], v1[1]); t.w = pk2(v1[2], v1[3]); ra[i] = t; }
            if (i < MI) rb[i] = *(const u32x4*)(Bt + (size_t)(n0 + r) * ldb + k0 + lc * 8);
            continue;
#endif
            ra[i] = coh_load16(A + (size_t)(m0 + r) * lda + k0 + lc * 8);
            if (i < MI) rb[i] = coh_load16(Bt + (size_t)(n0 + r) * ldb + k0 + lc * 8);
        } else {
            ra[i] = *(const u32x4*)(A + (size_t)(m0 + r) * lda + k0 + lc * 8);
            if (i < MI) rb[i] = *(const u32x4*)(Bt + (size_t)(n0 + r) * ldb + k0 + lc * 8);
        }
    }
}
template <int MI>
DEV void gemm_sstore(lds_char* st, const u32x4 (&ra)[4], const u32x4 (&rb)[MI]) {
    const int T = tidx();
#pragma unroll
    for (int i = 0; i < 4; ++i) {
        const int q = i * 256 + T;
        *(LDS u32x4*)(st + q * 16) = ra[i];
        if (i < MI) *(LDS u32x4*)(st + 16384 + q * 16) = rb[i];
    }
}
template <int MI, bool COH = false>
DEV void gemm_acc(f32x4 (&acc)[MI][4], const bf16_t* A, int lda, int m0, const bf16_t* Bt, int ldb, int n0, int K, lds_char* smem) {
    constexpr int WN = MI / 2;
    const int T = tidx(), lane = T & 63, w = T >> 6, wr = w / WN, wc = w % WN, fr = lane & 15, fq = lane >> 4;
    const int nt = K >> 6;
    u32x4 ra[4], rb[MI];
    gemm_gload<MI, COH>(A, lda, m0, Bt, ldb, n0, 0, ra, rb);
    __syncthreads();
    for (int t = 0; t < nt; ++t) {
        lds_char* a = smem + (t & 1) * 32768;
        lds_char* b = a + 16384;
        gemm_sstore<MI>(a, ra, rb);
        __syncthreads();
        if (t + 1 < nt) gemm_gload<MI, COH>(A, lda, m0, Bt, ldb, n0, (t + 1) * 64, ra, rb);
#pragma unroll
        for (int ks = 0; ks < 2; ++ks) {
            bf16x8 af[MI], bfr[4];
#pragma unroll
            for (int m = 0; m < MI; ++m) { const int r = wr * (MI * 16) + m * 16 + fr; af[m] = *(const LDS bf16x8*)(a + r * 128 + (((ks * 4 + fq) ^ (r & 7)) << 4)); }
#pragma unroll
            for (int n = 0; n < 4; ++n) { const int r = wc * 64 + n * 16 + fr; bfr[n] = *(const LDS bf16x8*)(b + r * 128 + (((ks * 4 + fq) ^ (r & 7)) << 4)); }
            __builtin_amdgcn_s_setprio(1);
#pragma unroll
            for (int m = 0; m < MI; ++m)
#pragma unroll
                for (int n = 0; n < 4; ++n) acc[m][n] = MFMA(bfr[n], af[m], acc[m][n]);
            __builtin_amdgcn_s_setprio(0);
        }
    }
}
template <int MI>
DEV void zero_acc(f32x4 (&acc)[MI][4]) {
#pragma unroll
    for (int m = 0; m < MI; ++m)
#pragma unroll
        for (int n = 0; n < 4; ++n) acc[m][n] = (f32x4){0.f, 0.f, 0.f, 0.f};
}
#define GEMM_IDS_(MI) const int T = tidx(), lane = T & 63, w = T >> 6, wr = w / ((MI) / 2), wc = w % ((MI) / 2), fr = lane & 15, fq = lane >> 4; constexpr int MI_ = (MI); (void)T; (void)lane; (void)w
#define GEMM_IDS GEMM_IDS_(4)
#define CROW(m) (m0 + wr * (MI_ * 16) + (m) * 16 + fr)
#define CCOL(n) (n0 + wc * 64 + (n) * 16 + fq * 4)

template <int MI>
DEV void epi_bf16(const f32x4 (&acc)[MI][4], bf16_t* dst, int ld, int m0, int n0) {
    GEMM_IDS_(MI);
    float one = 1.0f; asm volatile("" : "+v"(one));
#pragma unroll
    for (int m = 0; m < MI; ++m)
#pragma unroll
        for (int n = 0; n < 4; ++n) {
            const f32x4 a = acc[m][n] * one;
            u32x2 v; v.x = pk2(a[0], a[1]); v.y = pk2(a[2], a[3]);
            wt_store8(dst + (size_t)CROW(m) * ld + CCOL(n), v);
        }
}
DEV void epi_res(const f32x4 (&acc)[4][4], const float* res, float* out, int m0, int n0) {
    GEMM_IDS;
#pragma unroll
    for (int m = 0; m < 4; ++m)
#pragma unroll
        for (int n = 0; n < 4; ++n) {
            const size_t o = (size_t)CROW(m) * DM + CCOL(n);
            const f32x4 r = *(const f32x4*)(res + o);
            { f32x4 a = acc[m][n];
#ifdef DBG_SANITIZE
              for (int e = 0; e < 4; ++e) if (!(fabsf(a[e]) < 1e30f)) a[e] = 0.f;
#endif
              const f32x4 y = r * ALPHA + a; wt_store16(out + o, __builtin_bit_cast(u32x4, y)); }
        }
}

DEV void transpose_tile(const float* __restrict__ src, int N, bf16_t* __restrict__ dst, int K, int k0, int n0, lds_char* smem) {
    LDS float* t = (LDS float*)smem;
    const int T = tidx();
    __syncthreads();
#pragma unroll
    for (int i = 0; i < 4; ++i) {
        const int q = i * 256 + T, r = q >> 4, c = (q & 15) * 4;
        const f32x4 v = *(const f32x4*)(src + (size_t)(k0 + r) * N + n0 + c);
        t[r * 65 + c] = v[0]; t[r * 65 + c + 1] = v[1]; t[r * 65 + c + 2] = v[2]; t[r * 65 + c + 3] = v[3];
    }
    __syncthreads();
#pragma unroll
    for (int i = 0; i < 2; ++i) {
        const int q = i * 256 + T, rr = q >> 3, cc = (q & 7) * 8;
        u32x4 v;
        v.x = pk2(t[(cc + 0) * 65 + rr], t[(cc + 1) * 65 + rr]); v.y = pk2(t[(cc + 2) * 65 + rr], t[(cc + 3) * 65 + rr]);
        v.z = pk2(t[(cc + 4) * 65 + rr], t[(cc + 5) * 65 + rr]); v.w = pk2(t[(cc + 6) * 65 + rr], t[(cc + 7) * 65 + rr]);
        wt_store16(dst + (size_t)(n0 + rr) * K + k0 + cc, v);
    }
}
DEV void phase_prep(CParams& p, lds_char* smem) {
    const int G = gridDim.x, bid = blockIdx.x, T = tidx();
    bf16_t* WT = (bf16_t*)(p.ws + OFF_WT);
    for (int u = bid; u < 2 * 5984; u += G) {
        const int l = u / 5984; int t = u % 5984;
        const float* src; size_t doff; int K, N;
        if (t < 2048) { src = p.in[I_WIN] + (size_t)l * 1024 * 8192; doff = W_IN; K = 1024; N = 8192; }
        else if ((t -= 2048) < 128) { src = p.in[I_BRA] + (size_t)l * 512 * 1024; doff = W_BRA; K = 512; N = 1024; }
        else if ((t -= 128) < 256) { src = p.in[I_BRB] + (size_t)l * 1024 * 1024; doff = W_BRB; K = 1024; N = 1024; }
        else if ((t -= 256) < 128) { src = p.in[I_BRC] + (size_t)l * 512 * 1024; doff = W_BRC; K = 512; N = 1024; }
        else if ((t -= 128) < 256) { src = p.in[I_WOUT] + (size_t)l * 1024 * 1024; doff = W_OUT; K = 1024; N = 1024; }
        else if ((t -= 256) < 256) { src = p.in[I_XQ] + (size_t)l * 1024 * 1024; doff = W_XQ; K = 1024; N = 1024; }
        else if ((t -= 256) < 512) { src = p.in[I_XKV] + (size_t)l * 1024 * 2048; doff = W_XKV; K = 1024; N = 2048; }
        else if ((t -= 512) < 256) { src = p.in[I_XO] + (size_t)l * 1024 * 1024; doff = W_XO; K = 1024; N = 1024; }
        else if ((t -= 256) < 1408) { src = p.in[I_WUP] + (size_t)l * 1024 * 5632; doff = W_UP; K = 1024; N = 5632; }
        else if ((t -= 1408) < 704) { src = p.in[I_WDOWN] + (size_t)l * 2816 * 1024; doff = W_DOWN; K = 2816; N = 1024; }
        else { t -= 704; src = p.in[I_GATEW] + (size_t)l * 131072 + (size_t)t * 4096; doff = W_GW + (size_t)t * 4096; K = 64; N = 64; t = 0; }
        const int tn = N >> 6;
        transpose_tile(src, N, WT + (size_t)l * WL_ELEMS + doff, K, (t / tn) * 64, (t % tn) * 64, smem);
    }
    {
        const f32x4* x4 = (const f32x4*)p.in[I_X]; u32x2* xb = (u32x2*)(p.ws + OFF_XB);
        for (size_t i = (size_t)bid * 256 + T; i < (size_t)NTOK * DM / 4; i += (size_t)G * 256) { const f32x4 v = x4[i]; u32x2 o; o.x = pk2(v[0], v[1]); o.y = pk2(v[2], v[3]); wt_store8(&xb[i], o); }
        const f32x4* m4 = (const f32x4*)p.in[I_MEM]; u32x2* mb = (u32x2*)(p.ws + OFF_MEMB);
        for (size_t i = (size_t)bid * 256 + T; i < (size_t)2048 * DM / 4; i += (size_t)G * 256) { const f32x4 v = m4[i]; u32x2 o; o.x = pk2(v[0], v[1]); o.y = pk2(v[2], v[3]); wt_store8(&mb[i], o); }
    }
}

DEV void rot_coef(int pos, float invf, float& c, float& s) {
    const float ang = (float)pos * invf;
    const float n = rintf(ang * 0.15915494309189535f);
    float r = fmaf(-n, 6.2831854820251465f, ang);
    r = fmaf(-n, -1.7484556025237907e-07f, r);
    c = __cosf(r); s = __sinf(r);
}
DEV void phase_u(CParams& p, int l, lds_char* smem) {
    const int G = gridDim.x, bid = blockIdx.x;
    const bf16_t* xb = (const bf16_t*)(p.ws + OFF_XB);
    const bf16_t* WT = (const bf16_t*)(p.ws + OFF_WT) + (size_t)l * WL_ELEMS;
    const int nkv = 0;
#ifdef DBG_U_XQ
    const int nu = 512 * 48 + nkv;
#else
    const int nu = 512 * 40 + nkv;
#endif
    for (int uu = bid; uu < nu; uu += G) {
        f32x4 acc[4][4]; zero_acc<4>(acc);
        if (uu < nkv) {
            const int v = uu, ll = v >> 8, t = v & 255, m0 = (t >> 4) * 128, n0 = (t & 15) * 128;
            gemm_acc<4, false>(acc, (const bf16_t*)(p.ws + OFF_MEMB), 1024, m0, (const bf16_t*)(p.ws + OFF_WT) + (size_t)ll * WL_ELEMS + W_XKV, 1024, n0, 1024, smem);
            epi_bf16<4>(acc, (bf16_t*)(p.ws + OFF_MEMKV) + (size_t)ll * 2048 * 2048, 2048, m0, n0);
            continue;
        }
        const int u = uu - nkv;
#ifdef DBG_U_XQ
        const int m0 = (u / 48) * 128, n0 = (u % 48) * 128;
        gemm_acc<4>(acc, xb, 1024, m0, (n0 < 5120) ? (WT + W_IN) : (WT + (W_XQ - (size_t)5120 * 1024)), 1024, n0, 1024, smem);
        if (n0 >= 5120) { if (m0 < 16384) epi_bf16<4>(acc, (bf16_t*)(p.ws + 984 * MiB), 1024, m0, n0 - 5120); continue; }
#else
        const int m0 = (u / 40) * 128, n0 = (u % 40) * 128;
        gemm_acc<4>(acc, xb, 1024, m0, WT + W_IN, 1024, n0, 1024, smem);
#endif
        bf16_t* dst; int ld, c0; bool rot = false;
        if (n0 < 512) { dst = (bf16_t*)(p.ws + OFF_AQ); ld = 512; c0 = n0; rot = true; }
        else if (n0 < 1024) { dst = (bf16_t*)(p.ws + OFF_AK); ld = 512; c0 = n0 - 512; rot = true; }
        else if (n0 < 1536) { dst = (bf16_t*)(p.ws + OFF_AV); ld = 512; c0 = n0 - 1024; }
        else if (n0 < 2560) { dst = (bf16_t*)(p.ws + OFF_RX); ld = 1024; c0 = n0 - 1536; }
        else if (n0 < 3584) { dst = (bf16_t*)(p.ws + OFF_RG); ld = 1024; c0 = n0 - 2560; }
        else if (n0 < 4096) { dst = (bf16_t*)(p.ws + OFF_CQ); ld = 512; c0 = n0 - 3584; rot = true; }
        else if (n0 < 4608) { dst = (bf16_t*)(p.ws + OFF_CK); ld = 512; c0 = n0 - 4096; rot = true; }
        else { dst = (bf16_t*)(p.ws + OFF_CV); ld = 512; c0 = n0 - 4608; }
        GEMM_IDS;
        if (rot) {
            const bool hi = (fq & 2) != 0, odd = (fq & 1) != 0;
            const float f0 = odd ? 0.001414213562373095f : 1.0f, f1 = odd ? 0.0002742481756762073f : 0.19392274474868576f,
                        f2 = odd ? 5.318295896944988e-05f : 0.03760603093086393f, f3 = odd ? 1.031338537721246e-05f : 0.007292664737217109f;
#pragma unroll
            for (int m = 0; m < 4; ++m) {
                const int pos = CROW(m) & (SEQ - 1);
                f32x4 v = acc[m][0], o;
#pragma unroll
                for (int j = 0; j < 4; ++j) {
                    const float pv = __shfl_xor(v[j], 32);
                    float c, s; rot_coef(pos, j == 0 ? f0 : j == 1 ? f1 : j == 2 ? f2 : f3, c, s);
                    o[j] = hi ? (v[j] * c + pv * s) : (v[j] * c - pv * s);
                }
                acc[m][0] = o;
            }
        }
        epi_bf16<4>(acc, dst, ld, m0, c0);
    }
}

template <int D, int DV, int KW, int MT, int MODE, bool PF>
DEV void flash_core(const bf16_t* __restrict__ Qp, int ldq, int qtok0, int qstride, int qrow0,
                    const bf16_t* __restrict__ Kp, int ldk, const bf16_t* __restrict__ Vp, int ldv, int ktok0, int kstride,
                    int kt_begin, int kt_end, int koff, float sc, int qpos0, lds_char* smem,
                    f32x4 (&o)[MT][DV / 16], float (&mrow)[MT], float (&lrow)[MT]) {
    const int T = tidx(), lane = T & 63, fr = lane & 15, fq = lane >> 4;
    constexpr int KSTR = KW * 2 + 16, VSTR = DV * 2 + 32;
    lds_char* Ks = smem;
    lds_char* Vs = smem + 64 * KSTR;
    constexpr int KCH = KW / 8, NKL = 64 * KCH / 256, VCH = DV / 8, NVL = 64 * VCH / 256;
    bf16x8 qf[MT][D / 32];
#pragma unroll
    for (int mt = 0; mt < MT; ++mt)
#pragma unroll
        for (int ks = 0; ks < D / 32; ++ks)
            qf[mt][ks] = *(const bf16x8*)(Qp + (size_t)(qtok0 + (qrow0 + mt * 16 + fr) * qstride) * ldq + ks * 32 + fq * 8);
#pragma unroll
    for (int mt = 0; mt < MT; ++mt) {
        mrow[mt] = -1e30f; lrow[mt] = 0.f;
#pragma unroll
        for (int dt = 0; dt < DV / 16; ++dt) o[mt][dt] = (f32x4){0.f, 0.f, 0.f, 0.f};
    }
    u32x4 kreg[NKL], vreg[NVL];
    if (PF && kt_begin < kt_end) {
#pragma unroll
        for (int i = 0; i < NKL; ++i) { const int q = i * 256 + T, row = q / KCH, ch = q % KCH; kreg[i] = *(const u32x4*)(Kp + (size_t)(ktok0 + (kt_begin * 64 + row) * kstride) * ldk + ch * 8); }
#pragma unroll
        for (int i = 0; i < NVL; ++i) { const int q = i * 256 + T, row = q / VCH, ch = q % VCH; vreg[i] = *(const u32x4*)(Vp + (size_t)(ktok0 + (kt_begin * 64 + row) * kstride) * ldv + ch * 8); }
    }
    const int vbase = (4 * fq + ((lane >> 2) & 3)) * VSTR + (lane & 3) * 8;
    for (int kt = kt_begin; kt < kt_end; ++kt) {
        if (!PF) {
#pragma unroll
            for (int i = 0; i < NKL; ++i) { const int q = i * 256 + T, row = q / KCH, ch = q % KCH; kreg[i] = *(const u32x4*)(Kp + (size_t)(ktok0 + (kt * 64 + row) * kstride) * ldk + ch * 8); }
#pragma unroll
            for (int i = 0; i < NVL; ++i) { const int q = i * 256 + T, row = q / VCH, ch = q % VCH; vreg[i] = *(const u32x4*)(Vp + (size_t)(ktok0 + (kt * 64 + row) * kstride) * ldv + ch * 8); }
        }
        __syncthreads();
#pragma unroll
        for (int i = 0; i < NKL; ++i) { const int q = i * 256 + T, row = q / KCH, ch = q % KCH; *(LDS u32x4*)(Ks + row * KSTR + ch * 16) = kreg[i]; }
#pragma unroll
        for (int i = 0; i < NVL; ++i) { const int q = i * 256 + T, row = q / VCH, ch = q % VCH; *(LDS u32x4*)(Vs + row * VSTR + ch * 16) = vreg[i]; }
        __syncthreads();
        if (PF && kt + 1 < kt_end) {
#pragma unroll
            for (int i = 0; i < NKL; ++i) { const int q = i * 256 + T, row = q / KCH, ch = q % KCH; kreg[i] = *(const u32x4*)(Kp + (size_t)(ktok0 + ((kt + 1) * 64 + row) * kstride) * ldk + ch * 8); }
#pragma unroll
            for (int i = 0; i < NVL; ++i) { const int q = i * 256 + T, row = q / VCH, ch = q % VCH; vreg[i] = *(const u32x4*)(Vp + (size_t)(ktok0 + ((kt + 1) * 64 + row) * kstride) * ldv + ch * 8); }
        }
        bool act = true;
        if (MODE == 1) act = (64 * kt + 63 >= qrow0) && (64 * kt <= qrow0 + MT * 16 - 1 + 128);
        if (act) {
            const bool domask = (MODE == 0) ? (kt == kt_end - 1) : (MODE == 1);
            bf16x8 pf[MT][2];
#pragma unroll
            for (int mt = 0; mt < MT; ++mt) {
                f32x4 s[4];
#pragma unroll
                for (int n = 0; n < 4; ++n) s[n] = (f32x4){0.f, 0.f, 0.f, 0.f};
#pragma unroll
                for (int ks = 0; ks < D / 32; ++ks) {
#pragma unroll
                    for (int n = 0; n < 4; ++n) {
                        const bf16x8 kf = *(const LDS bf16x8*)(Ks + (n * 16 + fr) * KSTR + (koff + ks * 32 + fq * 8) * 2);
                        s[n] = MFMA(kf, qf[mt][ks], s[n]);
                    }
                }
                const int qi = qrow0 + mt * 16 + fr;
                float mx = -INFINITY;
#pragma unroll
                for (int n = 0; n < 4; ++n)
#pragma unroll
                    for (int j = 0; j < 4; ++j) {
                        float v = s[n][j] * sc;
                        if (domask) {
                            const int kj = kt * 64 + n * 16 + fq * 4 + j;
                            bool ok;
                            if (MODE == 0) ok = kj <= qpos0 + qi; else ok = (kj >= qi) && (kj <= qi + 128);
                            if (!ok) v = -INFINITY;
                        }
                        s[n][j] = v; mx = fmaxf(mx, v);
                    }
                mx = fmaxf(mx, __shfl_xor(mx, 16)); mx = fmaxf(mx, __shfl_xor(mx, 32));
                const float mn = fmaxf(mrow[mt], mx);
                const float alpha = fexp2(mrow[mt] - mn);
                mrow[mt] = mn;
                float rs = 0.f;
#pragma unroll
                for (int n = 0; n < 4; ++n)
#pragma unroll
                    for (int j = 0; j < 4; ++j) { const float pe = fexp2(s[n][j] - mn); s[n][j] = pe; rs += pe; }
                lrow[mt] = lrow[mt] * alpha + rs;
#pragma unroll
                for (int dt = 0; dt < DV / 16; ++dt) o[mt][dt] *= alpha;
#pragma unroll
                for (int k2 = 0; k2 < 2; ++k2) {
                    u32x4 t;
                    t.x = pk2(s[2 * k2][0], s[2 * k2][1]); t.y = pk2(s[2 * k2][2], s[2 * k2][3]);
                    t.z = pk2(s[2 * k2 + 1][0], s[2 * k2 + 1][1]); t.w = pk2(s[2 * k2 + 1][2], s[2 * k2 + 1][3]);
                    pf[mt][k2] = __builtin_bit_cast(bf16x8, t);
                }
            }
#pragma unroll
            for (int k2 = 0; k2 < 2; ++k2)
#pragma unroll
                for (int dt = 0; dt < DV / 16; ++dt) {
                    const s16x4 v0 = __builtin_amdgcn_ds_read_tr16_b64_v4i16((LDS s16x4*)(Vs + vbase + (k2 * 32) * VSTR + dt * 32));
                    const s16x4 v1 = __builtin_amdgcn_ds_read_tr16_b64_v4i16((LDS s16x4*)(Vs + vbase + (k2 * 32 + 16) * VSTR + dt * 32));
                    const bf16x8 vf = __builtin_shufflevector(v0, v1, 0, 1, 2, 3, 4, 5, 6, 7);
#pragma unroll
                    for (int mt = 0; mt < MT; ++mt) o[mt][dt] = MFMA(vf, pf[mt][k2], o[mt][dt]);
                }
        }
    }
}

DEV void diff_unit(CParams& p, int l, int unit, lds_char* smem) {
    const int T = tidx(), lane = T & 63, w = T >> 6, fr = lane & 15, fq = lane >> 4;
    const int jj = unit >> 9, gg = (unit >> 5) & 15;
    const int qt = 127 - 16 * jj - ((jj & 1) ? (15 - gg) : gg), bh = unit & 31, b = bh >> 2, h = bh & 3;
    const int comp = w >> 1, qrow0 = (w & 1) * 32;
    f32x4 o[2][8]; float mrow[2], lrow[2];
    bf16_t* aq = (bf16_t*)(p.ws + OFF_AQ);
    flash_core<64, 128, 128, 2, 0, false>(aq + h * 128 + comp * 64, 512, b * SEQ + qt * 64, 1, qrow0,
                                   (const bf16_t*)(p.ws + OFF_AK) + h * 128, 512, (const bf16_t*)(p.ws + OFF_AV) + h * 128, 512, b * SEQ, 1,
                                   0, qt + 1, comp * 64, 0.125f * LOG2E, qt * 64, smem, o, mrow, lrow);
    int l2 = l; asm volatile("" : "+s"(l2));
    const float linit = (l2 == 0) ? 0.2f : 0.35550906759096934f;
    float lam;
    {
        const float* lq = p.in[I_LAMQK] + l2 * 256;
        float s1 = lq[lane] * lq[64 + lane], s2 = lq[128 + lane] * lq[192 + lane];
#pragma unroll
        for (int o = 32; o >= 1; o >>= 1) { s1 += __shfl_xor(s1, o); s2 += __shfl_xor(s2, o); }
        lam = expf(s1) - expf(s2) + linit;
    }
#pragma unroll
    for (int mt = 0; mt < 2; ++mt) {
        float lt = lrow[mt]; lt += __shfl_xor(lt, 16); lt += __shfl_xor(lt, 32);
        const float inv = 1.0f / lt;
#pragma unroll
        for (int dt = 0; dt < 8; ++dt) o[mt][dt] *= inv;
    }
    __syncthreads();
    LDS float* X = (LDS float*)smem;
    if (comp == 1) {
#pragma unroll
        for (int mt = 0; mt < 2; ++mt)
#pragma unroll
            for (int dt = 0; dt < 8; ++dt) *(LDS f32x4*)(X + ((w & 1) * 32 + mt * 16 + fr) * 132 + dt * 16 + fq * 4) = o[mt][dt];
    }
    __syncthreads();
    if (comp == 0) {
        const float* g = p.in[I_SUBLN] + l * 128;
#pragma unroll
        for (int mt = 0; mt < 2; ++mt) {
            float ss = 0.f;
#pragma unroll
            for (int dt = 0; dt < 8; ++dt) {
                const f32x4 o2 = *(const LDS f32x4*)(X + ((w & 1) * 32 + mt * 16 + fr) * 132 + dt * 16 + fq * 4);
                o[mt][dt] = o[mt][dt] - lam * o2;
                ss += o[mt][dt][0] * o[mt][dt][0] + o[mt][dt][1] * o[mt][dt][1] + o[mt][dt][2] * o[mt][dt][2] + o[mt][dt][3] * o[mt][dt][3];
            }
            ss += __shfl_xor(ss, 16); ss += __shfl_xor(ss, 32);
            const float r = rsqrtf(ss * (1.0f / 128.0f) + 1e-5f) * (1.0f - linit);
            bf16_t* dst = aq + (size_t)(b * SEQ + qt * 64 + qrow0 + mt * 16 + fr) * 512 + h * 128 + fq * 4;
#pragma unroll
            for (int dt = 0; dt < 8; ++dt) {
                const f32x4 gg = *(const f32x4*)(g + dt * 16 + fq * 4);
                u32x2 v; v.x = pk2(o[mt][dt][0] * r * gg[0], o[mt][dt][1] * r * gg[1]); v.y = pk2(o[mt][dt][2] * r * gg[2], o[mt][dt][3] * r * gg[3]);
                wt_store8(dst + dt * 16, v);
            }
        }
    }
}

DEV void dil_unit(CParams& p, int pat, int unit, lds_char* smem) {
    const int T = tidx(), lane = T & 63, w = T >> 6, fr = lane & 15, fq = lane >> 4;
    const int dil = (pat == 0) ? 1 : (pat == 1) ? 4 : 16;
    const int bh = unit & 63, b = bh >> 3, head = bh & 7, pn = unit >> 6, ph = pn % dil, n = pn / dil;
    const int qrow0 = w * 32;
    f32x4 o[2][4]; float mrow[2], lrow[2];
    const int qtok0 = b * SEQ + n * 128 * dil + ph, ktok0 = b * SEQ + (n - 1) * 128 * dil + ph;
    flash_core<64, 64, 64, 2, 1, true>((const bf16_t*)(p.ws + OFF_CQ) + head * 64, 512, qtok0, dil, qrow0,
                                 (const bf16_t*)(p.ws + OFF_CK) + head * 64, 512, (const bf16_t*)(p.ws + OFF_CV) + head * 64, 512, ktok0, dil,
                                 (n == 0) ? 2 : 0, 4, 0, 0.125f * LOG2E, 0, smem, o, mrow, lrow);
    bf16_t* oc = (bf16_t*)(p.ws + OFF_OC);
    float* lsebuf = (float*)(p.ws + OFF_LSE);
#pragma unroll
    for (int mt = 0; mt < 2; ++mt) {
        float lt = lrow[mt]; lt += __shfl_xor(lt, 16); lt += __shfl_xor(lt, 32);
        const float inv = 1.0f / lt;
        float lse = (mrow[mt] + log2f(lt)) * LN2;
        const size_t tok = (size_t)qtok0 + (size_t)(qrow0 + mt * 16 + fr) * dil;
        bf16_t* dst = oc + tok * 512 + head * 64 + fq * 4;
        float wn = inv, wo = 0.f;
        if (pat > 0) {
            const float lo = lsebuf[tok * 8 + head];
            const float mxl = fmaxf(lo, lse);
            const float eo = fexp(lo - mxl), en = fexp(lse - mxl);
            const float tot = eo + en;
            wo = eo / tot; wn = inv * en / tot;
            lse = mxl + logf(tot);
        }
#pragma unroll
        for (int dt = 0; dt < 4; ++dt) {
            f32x4 v = o[mt][dt] * wn;
            if (pat > 0) { const u32x2 old = *(const u32x2*)(dst + dt * 16); v[0] += wo * bflo(old.x); v[1] += wo * bfhi(old.x); v[2] += wo * bflo(old.y); v[3] += wo * bfhi(old.y); }
            u32x2 r; r.x = pk2(v[0], v[1]); r.y = pk2(v[2], v[3]);
            wt_store8(dst + dt * 16, r);
        }
        if (pat < 2 && fq == 0) wt_store4f(&lsebuf[tok * 8 + head], lse);
    }
}

DEV void xattn_unit(CParams& p, int l, int unit, lds_char* smem) {
    const int T = tidx(), lane = T & 63, w = T >> 6, fr = lane & 15, fq = lane >> 4;
    const int h = unit & 3, tok0 = (unit >> 2) * 64, b = tok0 / SEQ;
    f32x4 o[1][16]; float mrow[1], lrow[1];
    bf16_t* qx = (bf16_t*)(p.ws + OFF_QX);
    const bf16_t* kv = (const bf16_t*)(p.ws + OFF_MEMKV) + (size_t)l * 2048 * 2048;
    flash_core<256, 256, 256, 1, 2, false>(qx + h * 256, 1024, tok0, 1, w * 16, kv + h * 256, 2048, kv + 1024 + h * 256, 2048, b * 256, 1,
                                    0, 4, 0, 0.0625f * LOG2E, 0, smem, o, mrow, lrow);
    float lt = lrow[0]; lt += __shfl_xor(lt, 16); lt += __shfl_xor(lt, 32);
    const float inv = 1.0f / lt;
    bf16_t* dst = qx + (size_t)(tok0 + w * 16 + fr) * 1024 + h * 256 + fq * 4;
#pragma unroll
    for (int dt = 0; dt < 16; ++dt) {
        u32x2 r; r.x = pk2(o[0][dt][0] * inv, o[0][dt][1] * inv); r.y = pk2(o[0][dt][2] * inv, o[0][dt][3] * inv);
        wt_store8(dst + dt * 16, r);
    }
}

DEV float neg_expm1(float x) {
    if (x > -0.3f) { float r = 1.0f / 720.0f; r = r * x + 1.0f / 120.0f; r = r * x + 1.0f / 24.0f; r = r * x + 1.0f / 6.0f; r = r * x + 0.5f; r = r * x + 1.0f; return -(r * x); }
    return 1.0f - fexp(x);
}
DEV float gelu_tanh(float x) {
    const float y = 0.7978845608028654f * (x + 0.044715f * x * x * x);
    const float t = 1.0f - 2.0f / (fexp(2.0f * y) + 1.0f);
    return 0.5f * x * (1.0f + t);
}
DEV void lru_unit(CParams& p, int l, int unit, int pass, lds_char* smem) {
    const int T = tidx(), lane = T & 63, w = T >> 6, fr = lane & 15, fq = lane >> 4;
    const int grp = unit & 3, c = (unit >> 2) & 127, b = unit >> 9;
    const int nb = grp * 4 + w, ch0 = nb * 64;
    lds_char* Xs = smem + w * 19456;
    lds_char* XCs = Xs + 9728;
    const bf16_t* rx = (const bf16_t*)(p.ws + OFF_RX);
    bf16_t* rg = (bf16_t*)(p.ws + OFF_RG);
    __syncthreads();
    for (int q = lane; q < 536; q += 64) {
        const int r = q >> 3, ch = q & 7, s = c * 64 + r - 3;
        u32x4 v = (u32x4){0u, 0u, 0u, 0u};
        if (s >= 0) v = *(const u32x4*)(rx + ((size_t)b * SEQ + s) * 1024 + ch0 + ch * 8);
        *(LDS u32x4*)(Xs + r * 144 + ch * 16) = v;
    }
    __syncthreads();
    {
        const int ch = lane & 7;
        const float* cw = p.in[I_CONVW] + (size_t)l * 4096 + ch0 + ch * 8;
        const float* cb = p.in[I_CONVB] + (size_t)l * 1024 + ch0 + ch * 8;
        float wv[4][8], bv[8];
#pragma unroll
        for (int e = 0; e < 8; ++e) { bv[e] = cb[e];
#pragma unroll
            for (int tp = 0; tp < 4; ++tp) wv[tp][e] = cw[tp * 1024 + e]; }
#pragma unroll
        for (int it = 0; it < 8; ++it) {
            const int t = it * 8 + (lane >> 3);
            float a[8];
#pragma unroll
            for (int e = 0; e < 8; ++e) a[e] = bv[e];
#pragma unroll
            for (int tp = 0; tp < 4; ++tp) {
                const u32x4 xv = *(const LDS u32x4*)(Xs + (t + tp) * 144 + ch * 16);
                a[0] += bflo(xv.x) * wv[tp][0]; a[1] += bfhi(xv.x) * wv[tp][1]; a[2] += bflo(xv.y) * wv[tp][2]; a[3] += bfhi(xv.y) * wv[tp][3];
                a[4] += bflo(xv.z) * wv[tp][4]; a[5] += bfhi(xv.z) * wv[tp][5]; a[6] += bflo(xv.w) * wv[tp][6]; a[7] += bfhi(xv.w) * wv[tp][7];
            }
            u32x4 ov; ov.x = pk2(a[0], a[1]); ov.y = pk2(a[2], a[3]); ov.z = pk2(a[4], a[5]); ov.w = pk2(a[6], a[7]);
            *(LDS u32x4*)(XCs + t * 144 + ch * 16) = ov;
        }
    }
    __syncthreads();
    const bf16_t* gw = (const bf16_t*)(p.ws + OFF_WT) + (size_t)l * WL_ELEMS + W_GW;
    bf16x8 gf[2][4][2];
#pragma unroll
    for (int g = 0; g < 2; ++g)
#pragma unroll
        for (int nt = 0; nt < 4; ++nt)
#pragma unroll
            for (int ks = 0; ks < 2; ++ks) gf[g][nt][ks] = *(const bf16x8*)(gw + ((size_t)(g * 16 + nb) * 64 + nt * 16 + fr) * 64 + ks * 32 + fq * 8);
    float sp[4], gb0[4], gb1[4], hin[4], atot[4];
#pragma unroll
    for (int nt = 0; nt < 4; ++nt) {
        const int ch = ch0 + nt * 16 + fr;
        const float lam = p.in[I_LAMBDA][l * 1024 + ch];
        const float x = fexp(-lam);
        sp[nt] = (x < 0.03f) ? x * (1.0f + x * (-0.5f + x * (1.0f / 3.0f + x * (-0.25f + x * 0.2f)))) : logf(1.0f + x);
        gb0[nt] = p.in[I_GATEB][l * 2048 + ch]; gb1[nt] = p.in[I_GATEB][l * 2048 + 1024 + ch];
        atot[nt] = 1.0f;
        hin[nt] = (pass == 1) ? ((const float*)(p.ws + OFF_LH))[((size_t)b * 128 + c) * 1024 + ch] : 0.0f;
    }
    for (int m = 0; m < 4; ++m) {
        f32x4 ar[4], ai[4];
#pragma unroll
        for (int nt = 0; nt < 4; ++nt) { ar[nt] = (f32x4){0.f, 0.f, 0.f, 0.f}; ai[nt] = (f32x4){0.f, 0.f, 0.f, 0.f}; }
#pragma unroll
        for (int ks = 0; ks < 2; ++ks) {
            const bf16x8 xa = *(const LDS bf16x8*)(XCs + (m * 16 + fr) * 144 + (ks * 32 + fq * 8) * 2);
#pragma unroll
            for (int nt = 0; nt < 4; ++nt) { ar[nt] = MFMA(xa, gf[0][nt][ks], ar[nt]); ai[nt] = MFMA(xa, gf[1][nt][ks], ai[nt]); }
        }
#pragma unroll
        for (int nt = 0; nt < 4; ++nt) {
            float Pj[4], Hj[4]; float P = 1.0f, Hh = 0.0f;
#pragma unroll
            for (int j = 0; j < 4; ++j) {
                const int tk = m * 16 + fq * 4 + j;
                const float xc = bf2f(*(const LDS bf16_t*)(XCs + tk * 144 + (nt * 16 + fr) * 2));
                const float r = sigmoidf_(ar[nt][j] + gb0[nt]), ig = sigmoidf_(ai[nt][j] + gb1[nt]);
                const float la = -8.0f * r * sp[nt];
                const float a = fexp(la);
                const float u = sqrtf(neg_expm1(2.0f * la)) * (ig * xc);
                Hh = a * Hh + u; P *= a; Pj[j] = P; Hj[j] = Hh;
            }
            float A1 = P, H1 = Hh;
            { const float ta = __shfl_up(A1, 16), th = __shfl_up(H1, 16); if (fq >= 1) { H1 = A1 * th + H1; A1 = A1 * ta; } }
            { const float ta = __shfl_up(A1, 32), th = __shfl_up(H1, 32); if (fq >= 2) { H1 = A1 * th + H1; A1 = A1 * ta; } }
            float Ea = __shfl_up(A1, 16), Eh = __shfl_up(H1, 16);
            if (fq == 0) { Ea = 1.0f; Eh = 0.0f; }
            const float Ta = __shfl(A1, 48 + fr), Th = __shfl(H1, 48 + fr);
            if (pass == 1) {
                const float h0 = Ea * hin[nt] + Eh;
#pragma unroll
                for (int j = 0; j < 4; ++j) {
                    const int tk = m * 16 + fq * 4 + j;
                    const float hv = Pj[j] * h0 + Hj[j];
                    bf16_t* gp = rg + ((size_t)b * SEQ + c * 64 + tk) * 1024 + ch0 + nt * 16 + fr;
                    const float gv = bf2f(*gp);
                    wt_store2(gp, (bf16_t)(pk2(hv * gelu_tanh(gv), 0.f) & 0xffffu));
                }
            }
            hin[nt] = Ta * hin[nt] + Th; atot[nt] *= Ta;
        }
    }
    if (pass == 0 && fq == 0) {
#pragma unroll
        for (int nt = 0; nt < 4; ++nt) {
            const size_t o = ((size_t)b * 128 + c) * 1024 + ch0 + nt * 16 + fr;
            wt_store4f((float*)(p.ws + OFF_LA) + o, atot[nt]); wt_store4f((float*)(p.ws + OFF_LH) + o, hin[nt]);
        }
    }
}
DEV void lru_carry(CParams& p) {
    float* LA = (float*)(p.ws + OFF_LA); float* LH = (float*)(p.ws + OFF_LH);
    for (int i = blockIdx.x * 256 + tidx(); i < NB * 1024; i += gridDim.x * 256) {
        const int b = i >> 10, ch = i & 1023;
        float carry = 0.f;
        for (int c = 0; c < 128; ++c) {
            const size_t o = ((size_t)b * 128 + c) * 1024 + ch;
            const float a = LA[o], h = LH[o];
            wt_store4f(&LH[o], carry); carry = a * carry + h;
        }
    }
}

DEV void phase_mix(CParams& p, int l, int which, lds_char* smem) {
    const int G = gridDim.x, bid = blockIdx.x;
    if (which == 0) {
        for (int u = bid; u < 4096; u += G) diff_unit(p, l, u, smem);
        for (int u = bid; u < 4096; u += G) dil_unit(p, 0, u, smem);
        for (int u = bid; u < 4096; u += G) lru_unit(p, l, u, 0, smem);
    } else if (which == 1) {
        lru_carry(p);
        for (int u = bid; u < 4096; u += G) dil_unit(p, 1, u, smem);
    } else {
        for (int u = bid; u < 4096; u += G) dil_unit(p, 2, u, smem);
#ifndef DBG_NO_LRU1
        for (int u = bid; u < 4096; u += G) lru_unit(p, l, u, 1, smem);
#endif
    }
}

DEV void phase_merge(CParams& p, int l, lds_char* smem) {
    const int G = gridDim.x, bid = blockIdx.x;
    const bf16_t* xb = (const bf16_t*)(p.ws + OFF_XB);
    const bf16_t* WT = (const bf16_t*)(p.ws + OFF_WT) + (size_t)l * WL_ELEMS;
    for (int u = bid; u < 512 * 8; u += G) {
        const int m0 = (u >> 3) * 128, n0 = (u & 7) * 128;
        f32x4 accM[4][4]; zero_acc<4>(accM);
#pragma unroll 1
        for (int i = 0; i < 3; ++i) {
            f32x4 acc[4][4]; zero_acc<4>(acc);
            gemm_acc<4>(acc, xb, 1024, m0, WT + W_IN + (size_t)(5120 + i * 1024) * 1024, 1024, n0, 1024, smem);
            unsigned gp[4][4][2];
#pragma unroll
            for (int m = 0; m < 4; ++m)
#pragma unroll
                for (int n = 0; n < 4; ++n) { gp[m][n][0] = pk2(sigmoidf_(acc[m][n][0]), sigmoidf_(acc[m][n][1])); gp[m][n][1] = pk2(sigmoidf_(acc[m][n][2]), sigmoidf_(acc[m][n][3])); }
            zero_acc<4>(acc);
            const bf16_t* A = (i == 0) ? (const bf16_t*)(p.ws + OFF_AQ) : (i == 1) ? (const bf16_t*)(p.ws + OFF_RG) : (const bf16_t*)(p.ws + OFF_OC);
            const int Ki = (i == 1) ? 1024 : 512;
            const bf16_t* Bt = WT + ((i == 0) ? W_BRA : (i == 1) ? W_BRB : W_BRC);
            gemm_acc<4>(acc, A, Ki, m0, Bt, Ki, n0, Ki, smem);
#pragma unroll
            for (int m = 0; m < 4; ++m)
#pragma unroll
                for (int n = 0; n < 4; ++n) {
                    accM[m][n][0] += bflo(gp[m][n][0]) * acc[m][n][0]; accM[m][n][1] += bfhi(gp[m][n][0]) * acc[m][n][1];
                    accM[m][n][2] += bflo(gp[m][n][1]) * acc[m][n][2]; accM[m][n][3] += bfhi(gp[m][n][1]) * acc[m][n][3];
                }
        }
        epi_bf16<4>(accM, (bf16_t*)(p.ws + OFF_MERGED), 1024, m0, n0);
    }
}
DEV void phase_gemm_res(CParams& p, const bf16_t* A, int K, const bf16_t* Bt, const float* res, lds_char* smem) {
    const int G = gridDim.x, bid = blockIdx.x;
    for (int u = bid; u < 512 * 8; u += G) {
        const int m0 = (u >> 3) * 128, n0 = (u & 7) * 128;
        f32x4 acc[4][4]; zero_acc<4>(acc);
        gemm_acc<4>(acc, A, K, m0, Bt, K, n0, K, smem);
        epi_res(acc, res, p.out, m0, n0);
    }
}
#ifndef XQ_COH
#define XQ_COH false
#endif
DEV void phase_xq(CParams& p, int l, lds_char* smem) {
    const int G = gridDim.x, bid = blockIdx.x;
    const bf16_t* WT = (const bf16_t*)(p.ws + OFF_WT) + (size_t)l * WL_ELEMS;
#ifdef DBG_XQ_DELAY
    { const unsigned long long t0 = __builtin_amdgcn_s_memrealtime(); while (__builtin_amdgcn_s_memrealtime() - t0 < 50000ull) __builtin_amdgcn_s_sleep(8); }
#endif
#ifdef DBG_XQ_A_MERGED
    const bf16_t* xb = (const bf16_t*)(p.ws + OFF_MERGED);
#elif defined(DBG_XB2)
    const bf16_t* xb = (const bf16_t*)(p.ws + 984 * MiB);
#elif defined(DBG_XQ_F32)
    const bf16_t* xb = (const bf16_t*)p.out;
#else
    const bf16_t* xb = (const bf16_t*)(p.ws + OFF_XB);
#endif
#ifndef DBG_XQW
#define DBG_XQW W_XQ
#endif
    const bf16_t* Wq = WT + DBG_XQW;
#ifdef DBG_XB2
    bf16_t* qx = (bf16_t*)(p.ws + OFF_QX);
    for (int u = bid; u < 128 * 8; u += G) {
#elif defined(DBG_QX_ALT)
    bf16_t* qx = (bf16_t*)(p.ws + 984 * MiB);
    for (int u = bid; u < 128 * 8; u += G) {
#else
    bf16_t* qx = (bf16_t*)(p.ws + OFF_QX);
    for (int u = bid; u < 512 * 8; u += G) {
#endif
#ifdef DBG_XQ_MAP2
        const int m0 = (u & 511) * 128, n0 = (u >> 9) * 128;
#else
        const int m0 = (u >> 3) * 128, n0 = (u & 7) * 128;
#endif
        f32x4 acc[4][4]; zero_acc<4>(acc);
        gemm_acc<4, XQ_COH>(acc, xb, 1024, m0, Wq, 1024, n0, 1024, smem);
        epi_bf16<4>(acc, qx, 1024, m0, n0);
    }
}
DEV void phase_memkv(CParams& p, int l, lds_char* smem) {
    const int G = gridDim.x, bid = blockIdx.x;
    const bf16_t* WT = (const bf16_t*)(p.ws + OFF_WT) + (size_t)l * WL_ELEMS;
    for (int t = bid; t < 256; t += G) {
        f32x4 acc[4][4]; zero_acc<4>(acc);
        const int m0 = (t >> 4) * 128, n0 = (t & 15) * 128;
        gemm_acc<4>(acc, (const bf16_t*)(p.ws + OFF_MEMB), 1024, m0, WT + W_XKV, 1024, n0, 1024, smem);
        epi_bf16<4>(acc, (bf16_t*)(p.ws + OFF_MEMKV) + (size_t)l * 2048 * 2048, 2048, m0, n0);
    }
}
DEV void phase_up(CParams& p, int l, lds_char* smem) {
    const int G = gridDim.x, bid = blockIdx.x;
    const bf16_t* WT = (const bf16_t*)(p.ws + OFF_WT) + (size_t)l * WL_ELEMS;
    const bf16_t* xb = (const bf16_t*)(p.ws + OFF_XB);
    for (int u = bid; u < 512 * 22; u += G) {
        const int m0 = (u / 22) * 128, n0 = (u % 22) * 128;
        f32x4 acc[4][4]; zero_acc<4>(acc);
        gemm_acc<4>(acc, xb, 1024, m0, WT + W_UP, 1024, n0, 1024, smem);
        unsigned gp[4][4][2];
#pragma unroll
        for (int m = 0; m < 4; ++m)
#pragma unroll
            for (int n = 0; n < 4; ++n) {
                f32x4 g = acc[m][n];
#pragma unroll
                for (int j = 0; j < 4; ++j) g[j] = g[j] * sigmoidf_(g[j]);
                gp[m][n][0] = pk2(g[0], g[1]); gp[m][n][1] = pk2(g[2], g[3]);
            }
        zero_acc<4>(acc);
        gemm_acc<4>(acc, xb, 1024, m0, WT + W_UP + (size_t)2816 * 1024, 1024, n0, 1024, smem);
#pragma unroll
        for (int m = 0; m < 4; ++m)
#pragma unroll
            for (int n = 0; n < 4; ++n) {
                acc[m][n][0] *= bflo(gp[m][n][0]); acc[m][n][1] *= bfhi(gp[m][n][0]); acc[m][n][2] *= bflo(gp[m][n][1]); acc[m][n][3] *= bfhi(gp[m][n][1]);
            }
        epi_bf16<4>(acc, (bf16_t*)(p.ws + OFF_HMID), 2816, m0, n0);
    }
}

DEV void phase_ln(CParams& p, const float* g, const float* bta) {
    const int lane = tidx() & 63, w = tidx() >> 6;
    f32x4 gv[4], bv[4];
#pragma unroll
    for (int i = 0; i < 4; ++i) { gv[i] = *(const f32x4*)(g + i * 256 + lane * 4); bv[i] = *(const f32x4*)(bta + i * 256 + lane * 4); }
    for (int row = blockIdx.x * 4 + w; row < NTOK; row += gridDim.x * 4) {
        float* xr = p.out + (size_t)row * DM;
        f32x4 v[4]; float s = 0.f;
#pragma unroll
        for (int i = 0; i < 4; ++i) { v[i] = *(const f32x4*)(xr + i * 256 + lane * 4); s += v[i][0] + v[i][1] + v[i][2] + v[i][3]; }
#pragma unroll
        for (int o = 32; o >= 1; o >>= 1) s += __shfl_xor(s, o);
        const float mean = s * (1.0f / 1024.0f);
        float q = 0.f;
#pragma unroll
        for (int i = 0; i < 4; ++i) { v[i] = v[i] - mean; q += v[i][0] * v[i][0] + v[i][1] * v[i][1] + v[i][2] * v[i][2] + v[i][3] * v[i][3]; }
#pragma unroll
        for (int o = 32; o >= 1; o >>= 1) q += __shfl_xor(q, o);
        const float rstd = rsqrtf(q * (1.0f / 1024.0f) + 1e-5f);
        bf16_t* xbr = (bf16_t*)(p.ws + OFF_XB) + (size_t)row * DM;
#pragma unroll
        for (int i = 0; i < 4; ++i) {
            f32x4 y = v[i] * rstd * gv[i] + bv[i];
#ifdef DBG_SANITIZE
            for (int e = 0; e < 4; ++e) if (!(fabsf(y[e]) < 1e30f)) y[e] = 0.f;
#endif
            wt_store16(xr + i * 256 + lane * 4, __builtin_bit_cast(u32x4, y));
            u32x2 r; r.x = pk2(y[0], y[1]); r.y = pk2(y[2], y[3]);
            wt_store8(xbr + i * 256 + lane * 4, r);
#ifdef DBG_XB2
            if (row < 16384) wt_store8((bf16_t*)(p.ws + 984 * MiB) + (size_t)row * DM + i * 256 + lane * 4, r);
#endif
        }
    }
}

#ifdef DBG_PH_HI
#define EN(k) ((k) < DBG_PH_HI - 1)
#else
#define EN(k) 1
#endif
constexpr int PH_PER_LAYER = 14, N_PHASES = 1 + 2 * PH_PER_LAYER;
DEV void run_phase(CParams& p, int ph, lds_char* smem) {
    if (ph == 0) { phase_prep(p, smem); return; }
    const int l = (ph - 1) / PH_PER_LAYER, k = (ph - 1) % PH_PER_LAYER;
    const bf16_t* WT = (const bf16_t*)(p.ws + OFF_WT) + (size_t)l * WL_ELEMS;
    switch (k) {
        case 0:
#if EN(0)
            phase_u(p, l, smem);
#ifdef DBG_XQ_IN_P1
            phase_xq(p, l, smem);
#endif
#endif
            break;
        case 1:
#if EN(1)
            phase_mix(p, l, 0, smem);
#endif
            break;
        case 2:
#if EN(2)
            phase_mix(p, l, 1, smem);
#endif
            break;
        case 3:
#if EN(3)
            phase_mix(p, l, 2, smem);
#endif
            break;
        case 4:
#if EN(4)
            phase_merge(p, l, smem);
#endif
            break;
        case 5:
#if EN(5)
            phase_gemm_res(p, (const bf16_t*)(p.ws + OFF_MERGED), 1024, WT + W_OUT, (l == 0) ? p.in[I_X] : p.out, smem);
#endif
            break;
        case 6:
#if EN(6) && !defined(DBG_SKIP_LN1)
            phase_ln(p, p.in[I_LN1G] + l * 1024, p.in[I_LN1B] + l * 1024);
#endif
            break;
        case 7:
#if EN(7)
            phase_xq(p, l, smem);
            phase_memkv(p, l, smem);
#endif
            break;
        case 8:
#if EN(8)
            for (int u = blockIdx.x; u < 4096; u += gridDim.x) xattn_unit(p, l, u, smem);
#endif
            break;
        case 9:
#if EN(9)
            phase_gemm_res(p, (const bf16_t*)(p.ws + OFF_QX), 1024, WT + W_XO, p.out, smem);
#endif
            break;
        case 10:
#if EN(10)
            phase_ln(p, p.in[I_LN2G] + l * 1024, p.in[I_LN2B] + l * 1024);
#endif
            break;
        case 11:
#if EN(11)
            phase_up(p, l, smem);
#endif
            break;
        case 12:
#if EN(12)
            phase_gemm_res(p, (const bf16_t*)(p.ws + OFF_HMID), 2816, WT + W_DOWN, p.out, smem);
#endif
            break;
        default:
#if EN(13)
            phase_ln(p, p.in[I_LN3G] + l * 1024, p.in[I_LN3B] + l * 1024);
#endif
            break;
    }
}

template <int K>
__global__ void __launch_bounds__(256, 2) phase_kernel(Params p, int l) {
    extern __shared__ __attribute__((aligned(16))) char smem_raw[];
    lds_char* smem = (lds_char*)smem_raw;
    CParams* kp = (CParams*)__builtin_amdgcn_kernarg_segment_ptr();
    CParams& q = *kp;
    const bf16_t* WT = (const bf16_t*)(q.ws + OFF_WT) + (size_t)l * WL_ELEMS;
    if (K == 99) phase_prep(q, smem);
    else if (K == 0) phase_u(q, l, smem);
    else if (K == 1) phase_mix(q, l, 0, smem);
    else if (K == 2) phase_mix(q, l, 1, smem);
    else if (K == 3) phase_mix(q, l, 2, smem);
    else if (K == 4) phase_merge(q, l, smem);
    else if (K == 5) phase_gemm_res(q, (const bf16_t*)(q.ws + OFF_MERGED), 1024, WT + W_OUT, (l == 0) ? q.in[I_X] : q.out, smem);
    else if (K == 6) phase_ln(q, q.in[I_LN1G] + l * 1024, q.in[I_LN1B] + l * 1024);
    else if (K == 7) phase_xq(q, l, smem);
    else if (K == 14) phase_memkv(q, l, smem);
    else if (K == 8) { for (int u = blockIdx.x; u < 4096; u += gridDim.x) xattn_unit(q, l, u, smem); }
    else if (K == 9) phase_gemm_res(q, (const bf16_t*)(q.ws + OFF_QX), 1024, WT + W_XO, q.out, smem);
    else if (K == 10) phase_ln(q, q.in[I_LN2G] + l * 1024, q.in[I_LN2B] + l * 1024);
    else if (K == 11) phase_up(q, l, smem);
    else if (K == 12) phase_gemm_res(q, (const bf16_t*)(q.ws + OFF_HMID), 2816, WT + W_DOWN, q.out, smem);
    else phase_ln(q, q.in[I_LN3G] + l * 1024, q.in[I_LN3B] + l * 1024);
}
#ifdef DBG_SPLIT_STOP
__global__ void __launch_bounds__(256, 2) dump_kernel(Params p) {
    const size_t NW = DBG_NW;
    for (size_t i = (size_t)blockIdx.x * 256 + threadIdx.x; i < 3 * NW; i += (size_t)gridDim.x * 256) {
        const size_t r = i / NW, j = i % NW;
        const size_t off = (r == 0) ? (size_t)DBG_DUMP_OFF : (r == 1) ? (size_t)DBG_DUMP_OFF2 : (size_t)DBG_DUMP_OFF3;
#ifdef DBG_DUMP_F32
        float a0 = p.out[2 * i], a1 = p.out[2 * i + 1];
#else
        const unsigned v = ((const unsigned*)(p.ws + off))[j]; float a0 = bflo(v), a1 = bfhi(v);
#endif
        const float mk = (r == 0) ? 1.0e3f : (r == 1) ? 1.0e5f : 1.0e7f;
        if (!(fabsf(a0) < 1e30f)) a0 = mk; if (!(fabsf(a1) < 1e30f)) a1 = mk;
        p.out[2 * i] = a0; p.out[2 * i + 1] = a1;
    }
}
#endif
template <int K>
static void launch_phase(const Params& p, int l, int grid, hipStream_t stream) {
    hipFuncSetAttribute((const void*)phase_kernel<K>, hipFuncAttributeMaxDynamicSharedMemorySize, SMEM_BYTES);
    hipLaunchKernelGGL(phase_kernel<K>, dim3(grid), dim3(256), SMEM_BYTES, stream, p, l);
}
__global__ void __launch_bounds__(256, 2) mega(Params p) {
    extern __shared__ __attribute__((aligned(16))) char smem_raw[];
    lds_char* smem = (lds_char*)smem_raw;
    cg::grid_group grid = cg::this_grid();
    const int ph_lo = p.ph_lo, ph_hi = p.ph_hi;
    unsigned nbar = 0;
    if (ph_lo < 0) grid.sync();
    for (int ph = ph_lo; ph < ph_hi; ++ph) {
        CParams* kp = (CParams*)__builtin_amdgcn_kernarg_segment_ptr();
        asm volatile("" : "+s"(kp));
#ifdef DBG_SELFCHECK
        if (ph == DBG_PH_HI + 1) {
            if (blockIdx.x == 0 && tidx() == 0) {
                const unsigned c = __hip_atomic_load((unsigned*)(kp->ws + 64), __ATOMIC_RELAXED, __HIP_MEMORY_SCOPE_AGENT);
                const float b = (float)((c + 16384u) / 32768u);
                kp->out[0] = 1.0e6f * b + 7.0e5f * (float)(c < 1000000u ? c : 999999u) / 1.0e6f * 0.f;
            }
        } else
#endif
#if defined(DBG_DUMP_OFF) && defined(DBG_PH_HI)
        if (ph == DBG_PH_HI) {
#ifndef DBG_NW
#define DBG_NW 10485760
#endif
#ifndef DBG_COLEXPR
#define DBG_COLEXPR (((int)(i & 15) * 61 + (int)(row & 63)) % DBG_NCOL)
#endif
#ifdef DBG_SELFCHECK
            {
                const bf16_t* Ap = (const bf16_t*)(kp->ws + DBG_A_OFF);
                const bf16_t* Wp = (const bf16_t*)(kp->ws + OFF_WT) + DBG_W_OFF;
                const bf16_t* Cp = (const bf16_t*)(kp->ws + DBG_C_OFF);
                for (size_t i = (size_t)blockIdx.x * 256 + tidx(); i < (size_t)DBG_ROWS * 16; i += (size_t)gridDim.x * 256) {
                    const size_t row = i >> 4; const int col = DBG_COLEXPR;
                    float acc = 0.f;
                    for (int k = 0; k < 1024; ++k) {
#ifdef DBG_A_FROM_X
                        const float av = bflo(pk2(kp->in[I_X][row * 1024 + k], 0.f));
#elif defined(DBG_A_FROM_OUT)
                        const float av = bflo(pk2(kp->out[row * 1024 + k], 0.f));
#else
                        const float av = bf2f(Ap[row * 1024 + k]);
#endif
                        acc += av * bf2f(Wp[(size_t)col * 1024 + k]); }
                    const float st = bf2f(Cp[row * DBG_LDC + col]);
                    if (!(fabsf(acc - st) <= 0.02f + 0.02f * fabsf(acc))) atomicAdd((unsigned*)(kp->ws + 64), 1u);
                }
            }
#else
            const size_t NW = DBG_NW;
            for (size_t i = (size_t)blockIdx.x * 256 + tidx(); i < 3 * NW; i += (size_t)gridDim.x * 256) {
                const size_t r = i / NW, j = i % NW;
                const size_t off = (r == 0) ? (size_t)DBG_DUMP_OFF : (r == 1) ? (size_t)DBG_DUMP_OFF2 : (size_t)DBG_DUMP_OFF3;
                const unsigned v = ((const unsigned*)(kp->ws + off))[j]; { float a0 = bflo(v), a1 = bfhi(v); if (!(fabsf(a0) < 1e30f)) a0 = 12345.0f; if (!(fabsf(a1) < 1e30f)) a1 = 12345.0f; kp->out[2 * i] = a0; kp->out[2 * i + 1] = a1; }
            }
#endif
        } else
#endif
        run_phase(*kp, ph, smem);
        if (ph + 1 < ph_hi) {
#ifdef DBG_SKEW
            if ((blockIdx.x & 15) == 3) { const unsigned long long t0 = __builtin_amdgcn_s_memrealtime(); while (__builtin_amdgcn_s_memrealtime() - t0 < 30000ull) __builtin_amdgcn_s_sleep(8); }
#endif
            asm volatile("s_waitcnt vmcnt(0)" ::: "memory");
            __syncthreads();
            ++nbar;
            if (tidx() == 0) {
                __builtin_amdgcn_fence(__ATOMIC_RELEASE, "agent");
                asm volatile("s_waitcnt vmcnt(0)" ::: "memory");
                unsigned* ctr = (unsigned*)kp->ws;
                __hip_atomic_fetch_add(ctr, 1u, __ATOMIC_RELAXED, __HIP_MEMORY_SCOPE_AGENT);
                const unsigned target = nbar * gridDim.x;
                while (__hip_atomic_load(ctr, __ATOMIC_RELAXED, __HIP_MEMORY_SCOPE_AGENT) < target) __builtin_amdgcn_s_sleep(2);
            }
            __syncthreads();
            __builtin_amdgcn_fence(__ATOMIC_ACQUIRE, "agent");
        }
    }
}

extern "C" void kernel_launch(void* const* d_in, const int* in_sizes, int n_in, void* d_out, int out_size, void* d_ws, size_t ws_size, hipStream_t stream) {
    static int grid_blocks = 0;
    hipFuncSetAttribute((const void*)mega, hipFuncAttributeMaxDynamicSharedMemorySize, SMEM_BYTES);
    if (!grid_blocks) {
        int dev = 0, cus = 0, per_cu = 0;
        hipGetDevice(&dev);
        hipDeviceGetAttribute(&cus, hipDeviceAttributeMultiprocessorCount, dev);
        hipOccupancyMaxActiveBlocksPerMultiprocessor(&per_cu, mega, 256, SMEM_BYTES);
        if (per_cu < 1) per_cu = 1;
        if (per_cu > 2) per_cu = 2;
        grid_blocks = cus * per_cu;
    }
    hipMemsetAsync(d_ws, 0, 256, stream);
#ifdef DBG_SELFCHECK
    hipMemsetAsync(d_out, 0, 256, stream);
#endif
    Params p{};
    for (int i = 0; i < 25; ++i) p.in[i] = (const float*)d_in[i];
    p.out = (float*)d_out; p.ws = (char*)d_ws; p.ph_lo = 0; p.ph_hi = N_PHASES;
#ifdef DBG_PH_HI
#ifdef DBG_SELFCHECK
    p.ph_hi = DBG_PH_HI + 2;
#else
    p.ph_hi = DBG_PH_HI + 1;
#endif
#endif
    if (ws_size < 980 * MiB) return;
#if defined(MK_SPLIT)
    hipError_t e = hipSuccess;
    launch_phase<99>(p, 0, grid_blocks, stream);
    int nrun = 0;
#ifdef DBG_SPLIT_STOP
    const int nmax = DBG_SPLIT_STOP;
#else
    const int nmax = 30;
#endif
#define LP(K) if (nrun++ < nmax) launch_phase<K>(p, l, grid_blocks, stream)
    for (int l = 0; l < 2; ++l) {
        LP(0); LP(1); LP(2); LP(3); LP(4); LP(5); LP(6); LP(7); LP(14); LP(8); LP(9); LP(10); LP(11); LP(12); LP(13);
    }
#ifdef DBG_SPLIT_STOP
    hipLaunchKernelGGL(dump_kernel, dim3(grid_blocks), dim3(256), 0, stream, p);
#endif
#elif defined(MK_MULTI)
    hipError_t e = hipSuccess;

    const int nph = p.ph_hi;
    for (int ph = 0; ph < nph; ++ph) {
        p.ph_lo = ph; p.ph_hi = ph + 1;
        hipLaunchKernelGGL(mega, dim3(grid_blocks), dim3(256), SMEM_BYTES, stream, p);
    }
#else
    void* args[] = {&p};
    hipError_t e = hipLaunchCooperativeKernel((void*)mega, dim3(grid_blocks), dim3(256), args, SMEM_BYTES, stream);
#endif
    if (e != hipSuccess) fprintf(stderr, "cooperative launch failed: %s (grid %d)\n", hipGetErrorString(e), grid_blocks);
}
```
